# Optimizing an MI355X kernel written in HIP

```python
import functools
import jax, jax.numpy as jnp
from jax import lax
import numpy as np

D_MODEL = 2048
BATCH = 4
SEQ = 2048
DEPTH = 1
DEC_BATCH = 128
DEC_SEQ = 8
PAST_LEN = 16384
PAGE_SIZE = 128

DN_HEADS = 8
DN_DK = 128
DN_DV = 128
DN_CONV = 4
DN_QK = DN_HEADS * DN_DK
DN_VW = DN_HEADS * DN_DV
DN_QKV = 2 * DN_QK + DN_VW
ML_HEADS = 4
ML_DK = 128
ML_DV = 256
ML_QK = ML_HEADS * ML_DK
ML_VW = ML_HEADS * ML_DV
MIX_WIDTH = DN_VW + ML_VW
D_FF = 5632
FFN_CONV = 3
CHUNK = 64
EPS = 1e-6
PROJ_SIZES = (DN_QKV, DN_VW, DN_HEADS, DN_HEADS, ML_QK, ML_QK, ML_VW, ML_VW, ML_HEADS, ML_HEADS)
PROJ_COLS = DN_QKV + DN_VW + 2 * DN_HEADS + 2 * ML_QK + 2 * ML_VW + 2 * ML_HEADS

kernel_name = "hymba_gdn_mlstm_convffn_step"


def _rmsnorm(x, g):
    xf = x.astype(jnp.float32)
    y = xf * lax.rsqrt(jnp.mean(xf * xf, axis=-1, keepdims=True) + EPS)
    return (y * g.astype(jnp.float32)).astype(x.dtype)


def _l2norm(x):
    return x * lax.rsqrt(jnp.sum(x * x, axis=-1, keepdims=True) + EPS)


def _causal_dwconv(x, buf, w):
    width, L = w.shape[0], x.shape[1]
    xp = jnp.concatenate([buf.astype(jnp.float32), x.astype(jnp.float32)], axis=1)
    wf = w.astype(jnp.float32)
    out = sum(xp[:, j:j + L] * wf[j] for j in range(width))
    return out, xp[:, L:]


def _chunk_size(L):
    return CHUNK if L % CHUNK == 0 else L


def _to_chunks(t, n, c):
    t = t.reshape((t.shape[0], n, c) + t.shape[2:])
    return jnp.swapaxes(jnp.swapaxes(t, 0, 1), 2, 3)


def _from_chunks(o):
    n, b, h, c, d = o.shape
    return o.transpose(1, 0, 3, 2, 4).reshape(b, n * c, h, d)


def _gated_delta_rule(q, k, v, g, beta, S0):
    L = q.shape[1]
    c = _chunk_size(L)
    n = L // c
    q, k, v, g, beta = (_to_chunks(t, n, c) for t in (q, k, v, g, beta))
    G = jnp.cumsum(g, axis=-1)
    tril = jnp.tril(jnp.ones((c, c), dtype=bool))
    strict = jnp.tril(jnp.ones((c, c), dtype=bool), -1)
    decay = jnp.exp(jnp.where(tril, G[..., :, None] - G[..., None, :], -jnp.inf))
    kb = k * beta[..., None]
    lower = jnp.where(strict, jnp.einsum('nbhik,nbhjk->nbhij', kb, k) * decay, 0.0)
    a_mat = lower + jnp.eye(c, dtype=lower.dtype)
    solve = functools.partial(lax.linalg.triangular_solve, left_side=True, lower=True, unit_diagonal=True)
    u = solve(a_mat, v * beta[..., None])
    w = solve(a_mat, kb * jnp.exp(G)[..., None])
    qk = jnp.einsum('nbhik,nbhjk->nbhij', q, k) * decay
    qe = q * jnp.exp(G)[..., None]
    G_last = G[..., -1:]
    kd = k * jnp.exp(G_last - G)[..., None]
    gl = jnp.exp(G_last[..., 0])

    def step(S, xs):
        qe_c, qk_c, u_c, w_c, kd_c, gl_c = xs
        v_new = u_c - jnp.einsum('bhck,bhkv->bhcv', w_c, S)
        o = jnp.einsum('bhck,bhkv->bhcv', qe_c, S) + jnp.einsum('bhij,bhjv->bhiv', qk_c, v_new)
        S = S * gl_c[..., None, None] + jnp.einsum('bhck,bhcv->bhkv', kd_c, v_new)
        return S, o

    S, o = lax.scan(step, S0, (qe, qk, u, w, kd, gl))
    return _from_chunks(o), S


def _mlstm(q, k, v, ig, logf, C0, n0, m0):
    L = q.shape[1]
    c = _chunk_size(L)
    n = L // c
    q, k, v, ig, logf = (_to_chunks(t, n, c) for t in (q, k, v, ig, logf))
    tril = jnp.tril(jnp.ones((c, c), dtype=bool))

    def step(carry, xs):
        Cm, nv, m = carry
        q_c, k_c, v_c, i_c, f_c = xs
        b = jnp.cumsum(f_c, axis=-1)
        D = jnp.where(tril, b[..., :, None] - b[..., None, :] + i_c[..., None, :], -jnp.inf)
        m_new = jnp.maximum(b + m[..., None], jnp.max(D, axis=-1))
        inter = jnp.exp(b + m[..., None] - m_new)
        s = jnp.einsum('bhik,bhjk->bhij', q_c, k_c) * jnp.exp(D - m_new[..., None])
        num = inter[..., None] * jnp.einsum('bhck,bhkv->bhcv', q_c, Cm) + jnp.einsum('bhij,bhjv->bhiv', s, v_c)
        den = inter * jnp.einsum('bhck,bhk->bhc', q_c, nv) + jnp.sum(s, axis=-1)
        h = num / jnp.maximum(jnp.abs(den), jnp.exp(-m_new))[..., None]
        m_end = m_new[..., -1]
        w_end = jnp.exp(b[..., -1:] - b + i_c - m_end[..., None])
        carry_scale = jnp.exp(b[..., -1] + m - m_end)
        Cm = carry_scale[..., None, None] * Cm + jnp.einsum('bhck,bhcv->bhkv', k_c * w_end[..., None], v_c)
        nv = carry_scale[..., None] * nv + jnp.einsum('bhck,bhc->bhk', k_c, w_end)
        return (Cm, nv, m_end), h

    (Cm, nv, m), h = lax.scan(step, (C0, n0, m0), (q, k, v, ig, logf))
    return _from_chunks(h), Cm, nv, m


def _layer(x, st, p):
    conv_buf, S0, C0, n0, m0, ffn_buf = st
    (norm_mix_g, w_in, dn_conv_w, dn_A_log, dn_dt_bias, dn_norm_g, ml_i_bias, ml_f_bias,
     ml_norm_g, w_out, norm_ffn_g, w_up, ffn_conv_w, ffn_conv_b, w_down) = p
    f32 = jnp.float32
    B, L, _ = x.shape
    h = _rmsnorm(x, norm_mix_g)
    proj = jnp.einsum('bld,de->ble', h, w_in)
    idx = np.cumsum(PROJ_SIZES)[:-1].tolist()
    dn_qkv, dn_z, dn_b, dn_a, ml_q, ml_k, ml_v, ml_o, ml_i, ml_f = jnp.split(proj, idx, axis=-1)

    qkv_c, conv_new = _causal_dwconv(dn_qkv, conv_buf, dn_conv_w)
    qkv_c = jax.nn.silu(qkv_c)
    dq, dkk, dvv = jnp.split(qkv_c, [DN_QK, 2 * DN_QK], axis=-1)
    dq = _l2norm(dq.reshape(B, L, DN_HEADS, DN_DK)) * (DN_DK ** -0.5)
    dkk = _l2norm(dkk.reshape(B, L, DN_HEADS, DN_DK))
    dvv = dvv.reshape(B, L, DN_HEADS, DN_DV)
    beta = jax.nn.sigmoid(dn_b.astype(f32))
    g = -jnp.exp(dn_A_log.astype(f32)) * jax.nn.softplus(dn_a.astype(f32) + dn_dt_bias.astype(f32))
    o_dn, S_new = _gated_delta_rule(dq, dkk, dvv, g, beta, S0.astype(f32))
    o_dn = _rmsnorm(o_dn, dn_norm_g) * jax.nn.silu(dn_z.astype(f32).reshape(B, L, DN_HEADS, DN_DV))

    mq = ml_q.astype(f32).reshape(B, L, ML_HEADS, ML_DK) * (ML_DK ** -0.5)
    mk = ml_k.astype(f32).reshape(B, L, ML_HEADS, ML_DK)
    mv = ml_v.astype(f32).reshape(B, L, ML_HEADS, ML_DV)
    ig = ml_i.astype(f32) + ml_i_bias.astype(f32)
    logf = jax.nn.log_sigmoid(ml_f.astype(f32) + ml_f_bias.astype(f32))
    h_ml, C_new, n_new, m_new = _mlstm(mq, mk, mv, ig, logf, C0.astype(f32), n0.astype(f32), m0.astype(f32))
    o_ml = _rmsnorm(h_ml, ml_norm_g.reshape(ML_HEADS, ML_DV)) * jax.nn.sigmoid(ml_o.astype(f32).reshape(B, L, ML_HEADS, ML_DV))

    mix = jnp.concatenate([o_dn.reshape(B, L, DN_VW), o_ml.reshape(B, L, ML_VW)], axis=-1).astype(x.dtype)
    x = x + jnp.einsum('ble,ed->bld', mix, w_out)

    h = _rmsnorm(x, norm_ffn_g)
    u = jnp.einsum('bld,df->blf', h, w_up)
    uc, ffn_new = _causal_dwconv(u, ffn_buf, ffn_conv_w)
    uc = uc + ffn_conv_b.astype(f32)
    gate, up = jnp.split(uc, 2, axis=-1)
    x = x + jnp.einsum('blf,fd->bld', (jax.nn.silu(gate) * up).astype(x.dtype), w_down)
    new_st = (conv_new.astype(conv_buf.dtype), S_new.astype(S0.dtype), C_new.astype(C0.dtype),
              n_new.astype(n0.dtype), m_new.astype(m0.dtype), ffn_new.astype(ffn_buf.dtype))
    return x, new_st


def setup_inputs(seed: int = 0) -> dict:
    key = jax.random.key(seed)
    ks = jax.random.split(key, 32)
    nrm = lambda k, s, sc=1.0: jax.random.normal(k, s, jnp.float32) * sc
    dt = jnp.exp(jax.random.uniform(ks[10], (DEPTH, DN_HEADS), jnp.float32, np.log(1e-3), np.log(1e-1)))
    return {
        "x_prompt": nrm(ks[0], (BATCH, SEQ, D_MODEL)),
        "x_sample": nrm(ks[1], (DEC_BATCH, DEC_SEQ, D_MODEL)),
        "state_dn_conv": nrm(ks[2], (DEPTH, DEC_BATCH, DN_CONV - 1, DN_QKV)),
        "state_dn_S": nrm(ks[3], (DEPTH, DEC_BATCH, DN_HEADS, DN_DK, DN_DV), 0.1),
        "state_ml_C": nrm(ks[4], (DEPTH, DEC_BATCH, ML_HEADS, ML_DK, ML_DV), 0.1),
        "state_ml_n": jnp.abs(nrm(ks[5], (DEPTH, DEC_BATCH, ML_HEADS, ML_DK), 0.1)),
        "state_ml_m": nrm(ks[6], (DEPTH, DEC_BATCH, ML_HEADS)),
        "state_ffn_conv": nrm(ks[7], (DEPTH, DEC_BATCH, FFN_CONV - 1, 2 * D_FF)),
        "norm_mix_g": 1.0 + nrm(ks[8], (DEPTH, D_MODEL), 0.02),
        "w_in": nrm(ks[9], (DEPTH, D_MODEL, PROJ_COLS), D_MODEL ** -0.5),
        "dn_conv_w": nrm(ks[11], (DEPTH, DN_CONV, DN_QKV), DN_CONV ** -0.5),
        "dn_A_log": jnp.log(jax.random.uniform(ks[12], (DEPTH, DN_HEADS), jnp.float32, 1.0, 16.0)),
        "dn_dt_bias": dt + jnp.log(-jnp.expm1(-dt)),
        "dn_norm_g": 1.0 + nrm(ks[13], (DEPTH, DN_DV), 0.02),
        "ml_i_bias": -3.0 + nrm(ks[14], (DEPTH, ML_HEADS), 0.1),
        "ml_f_bias": jnp.linspace(3.0, 6.0, ML_HEADS, dtype=jnp.float32) + nrm(ks[15], (DEPTH, ML_HEADS), 0.1),
        "ml_norm_g": 1.0 + nrm(ks[16], (DEPTH, ML_VW), 0.02),
        "w_out": nrm(ks[17], (DEPTH, MIX_WIDTH, D_MODEL), MIX_WIDTH ** -0.5),
        "norm_ffn_g": 1.0 + nrm(ks[18], (DEPTH, D_MODEL), 0.02),
        "w_up": nrm(ks[19], (DEPTH, D_MODEL, 2 * D_FF), D_MODEL ** -0.5),
        "ffn_conv_w": nrm(ks[20], (DEPTH, FFN_CONV, 2 * D_FF), FFN_CONV ** -0.5),
        "ffn_conv_b": nrm(ks[21], (DEPTH, 2 * D_FF), 0.02),
        "w_down": nrm(ks[22], (DEPTH, D_FF, D_MODEL), D_FF ** -0.5),
        "norm_final_g": 1.0 + nrm(ks[23], (D_MODEL,), 0.02),
    }


def reference(x_prompt, x_sample, state_dn_conv, state_dn_S, state_ml_C, state_ml_n, state_ml_m,
              state_ffn_conv, norm_mix_g, w_in, dn_conv_w, dn_A_log, dn_dt_bias, dn_norm_g,
              ml_i_bias, ml_f_bias, ml_norm_g, w_out, norm_ffn_g, w_up, ffn_conv_w, ffn_conv_b,
              w_down, norm_final_g):
    weights = (norm_mix_g, w_in, dn_conv_w, dn_A_log, dn_dt_bias, dn_norm_g, ml_i_bias, ml_f_bias,
               ml_norm_g, w_out, norm_ffn_g, w_up, ffn_conv_w, ffn_conv_b, w_down)
    states = (state_dn_conv, state_dn_S, state_ml_C, state_ml_n, state_ml_m, state_ffn_conv)
    xp, xs = x_prompt, x_sample
    p_new = [[] for _ in states]
    s_new = [[] for _ in states]
    for l in range(DEPTH):
        p = tuple(w[l] for w in weights)
        st_p = tuple(jnp.zeros((BATCH,) + s.shape[2:], s.dtype) for s in states)
        st_s = tuple(s[l] for s in states)
        xp, np_st = _layer(xp, st_p, p)
        xs, ns_st = _layer(xs, st_s, p)
        for i in range(len(states)):
            p_new[i].append(np_st[i])
            s_new[i].append(ns_st[i])
    y_prompt = _rmsnorm(xp, norm_final_g)
    y_sample = _rmsnorm(xs, norm_final_g)
    p_dn_conv, p_dn_S, p_ml_C, p_ml_n, p_ml_m, p_ffn_conv = (jnp.stack(a, axis=0) for a in p_new)
    s_dn_conv, s_dn_S, s_ml_C, s_ml_n, s_ml_m, s_ffn_conv = (jnp.stack(a, axis=0) for a in s_new)
    return (y_prompt, y_sample, p_dn_conv, p_dn_S, p_ml_C, p_ml_n, p_ml_m, p_ffn_conv,
            s_dn_conv, s_dn_S, s_ml_C, s_ml_n, s_ml_m, s_ffn_conv)
```

```cpp
#include <hip/hip_runtime.h>
#include <hip/hip_cooperative_groups.h>
#include <cstdio>
namespace cg = cooperative_groups;

#define LAS __attribute__((address_space(3)))
typedef unsigned short bf16_t;
typedef short bf16x8 __attribute__((ext_vector_type(8)));
typedef float f32x4 __attribute__((ext_vector_type(4)));
typedef unsigned u32x4 __attribute__((ext_vector_type(4)));
typedef unsigned u32x2 __attribute__((ext_vector_type(2)));

constexpr int DM = 2048, NTOK = 9216, NPT = 8192, SEQL = 2048;
constexpr int PCOL = 7168, PROJ_COLS = 7192, FF = 5632, FF2 = 11264;
constexpr int PC_DNZ = 3072, PC_MLQ = 4096, PC_MLK = 4608, PC_MLV = 5120, PC_MLO = 6144;
constexpr float EPS = 1e-6f;
constexpr int LDS_BYTES = 139264;
#ifndef DUP_P0
#define DUP_P0 0
#endif
#ifndef DUP_P1
#define DUP_P1 0
#endif
#ifndef DUP_P2
#define DUP_P2 0
#endif
#ifndef DUP_P3
#define DUP_P3 0
#endif
#ifndef DUP_P5
#define DUP_P5 0
#endif
#ifndef DUP_P6
#define DUP_P6 0
#endif

constexpr size_t O_Y = 0;
constexpr size_t O_P_DNCONV = 18874368;
constexpr size_t O_P_DNS = O_P_DNCONV + 36864;
constexpr size_t O_P_MLC = O_P_DNS + 524288;
constexpr size_t O_P_MLN = O_P_MLC + 524288;
constexpr size_t O_P_MLM = O_P_MLN + 2048;
constexpr size_t O_P_FFN = O_P_MLM + 16;
constexpr size_t O_S_DNCONV = O_P_FFN + 90112;
constexpr size_t O_S_DNS = O_S_DNCONV + 1179648;
constexpr size_t O_S_MLC = O_S_DNS + 16777216;
constexpr size_t O_S_MLN = O_S_MLC + 16777216;
constexpr size_t O_S_MLM = O_S_MLN + 65536;
constexpr size_t O_S_FFN = O_S_MLM + 512;
constexpr size_t O_TOTAL = O_S_FFN + 2883584;

constexpr size_t W_PROJ = 0;
constexpr size_t W_ITEMS = 132120576;
constexpr size_t W_WIN = 216006656;
constexpr size_t W_XB = W_WIN + 29360128;
constexpr size_t W_MIX = W_XB + 37748736;
constexpr size_t W_WOUT = W_MIX + 37748736;
constexpr size_t W_WUP = W_WOUT + 8388608;
constexpr size_t W_WDOWN = W_WUP + 46137344;
constexpr size_t W_RSTD1 = W_WDOWN + 23068672;
constexpr size_t W_GATES = W_RSTD1 + 36864;
constexpr size_t W_SSP2 = W_GATES + 1179648;
constexpr size_t W_SSP3 = W_SSP2 + 1179648;
constexpr size_t W_END = W_SSP3 + 1179648;
constexpr size_t W_MLKV = W_WIN;
constexpr size_t W_MLCS = W_WIN + 33554432;
constexpr size_t W_MLN = W_SSP3 + 1179648;
constexpr size_t W_MLNS = W_MLN + 262144;
constexpr size_t W_MLSC = W_MLNS + 262144;
constexpr size_t W_CTR = W_MLSC + 8192;
constexpr size_t W_BAR = W_CTR + 256;
constexpr size_t W_END2 = W_BAR + 16384;
constexpr int ITEM_STRIDE = 81920, IT_W = 0, IT_QE = 17408, IT_QK = 34816, IT_KDT = 44032, IT_UT = 62464, IT_GL = 80896, ITEM_COPY16 = 5057;

struct Params { const float* in[24]; float* out; unsigned char* ws; };

typedef __bf16 bf16x2_t __attribute__((ext_vector_type(2)));
typedef float f32x2_t __attribute__((ext_vector_type(2)));
__device__ __forceinline__ unsigned pk_bf16(float lo, float hi) { const f32x2_t v = {lo, hi}; const bf16x2_t r = __builtin_convertvector(v, bf16x2_t); return __builtin_bit_cast(unsigned, r); }
__device__ __forceinline__ float bf_lo(unsigned u) { return __uint_as_float(u << 16); }
__device__ __forceinline__ float bf_hi(unsigned u) { return __uint_as_float(u & 0xffff0000u); }
__device__ __forceinline__ float bf2f(bf16_t b) { return __uint_as_float(((unsigned)b) << 16); }
__device__ __forceinline__ bf16_t f2bf(float f) { return (bf16_t)(pk_bf16(f, 0.f) & 0xffffu); }
__device__ __forceinline__ float siluf(float x) { return x * __builtin_amdgcn_rcpf(1.f + __expf(-x)); }
__device__ __forceinline__ float sigm(float x) { return __builtin_amdgcn_rcpf(1.f + __expf(-x)); }
__device__ __forceinline__ float softplusf(float x) { return x > 20.f ? x : log1pf(__expf(x)); }
__device__ __forceinline__ float logsigm(float x) { return fminf(x, 0.f) - log1pf(__expf(-fabsf(x))); }
__device__ __forceinline__ u32x4 pack8(const f32x4 a, const f32x4 b) { u32x4 w; w.x = pk_bf16(a[0], a[1]); w.y = pk_bf16(a[2], a[3]); w.z = pk_bf16(b[0], b[1]); w.w = pk_bf16(b[2], b[3]); return w; }
__device__ __forceinline__ bf16x8 as_bf16x8(u32x4 w) { return __builtin_bit_cast(bf16x8, w); }
__device__ __forceinline__ int opaque_tid() { int t = threadIdx.x; asm volatile("" : "+v"(t)); return t; }
__device__ __forceinline__ float wave_sum(float v) {
#pragma unroll
    for (int d = 32; d >= 1; d >>= 1) v += __shfl_xor(v, d);
    return v;
}
__device__ __forceinline__ const float* xrow(const Params& p, int row) { return row < NPT ? p.in[0] + (size_t)row * DM : p.in[1] + (size_t)(row - NPT) * DM; }

namespace pg8 {
constexpr int BM = 256, BK = 64, HALF = 128, HTB = HALF * BK * 2, STAGE_BYTES = 8 * HTB, NXCD = 8, WGM = 8;
__device__ __forceinline__ int lds_byte(int r, int c) { const int st = (r >> 4) * 2 + (c >> 5), rr = r & 15, cc = c & 31, ob = rr * 64 + cc * 2; return st * 1024 + (ob ^ (((ob >> 9) & 1) << 5)); }
__device__ __forceinline__ void stage_rc(int b, int& R, int& C) { const int st = b / 1024, sb = b % 1024, swz = sb ^ (((sb >> 9) & 1) << 5); R = (st >> 1) * 16 + swz / 64; C = (st & 1) * 32 + (swz % 64) / 2; }
__device__ __forceinline__ int perm32(int rho) { const int n = rho >> 4, i = rho & 15; return 8 * (i >> 2) + 4 * n + (i & 3); }
struct Unit { int pm, pn, ks; };
struct Gemm { const bf16_t* A; const bf16_t* Bt; int M, N, K, ld, nsplit; };
struct StaticOrder {
    int nM, nN, nwg, G, c;
    __device__ void init(int M, int N, int G_, int c_) { nM = M / BM; nN = N / BM; nwg = nM * nN; G = G_; c = c_; }
    __device__ bool next(int i, Unit& u) const {
        const long L = (long)i * G + c; if (L >= nwg) return false;
        int wgid = (int)L; { const int q = nwg / NXCD, r = nwg % NXCD, xcd = wgid % NXCD, off = wgid / NXCD; wgid = (xcd < r ? xcd * (q + 1) : r * (q + 1) + (xcd - r) * q) + off; }
        const int nig = WGM * nN, gid = wgid / nig, fm = gid * WGM, gsz = (nM - fm) < WGM ? (nM - fm) : WGM;
        u.pm = fm + ((wgid % nig) % gsz); u.pn = (wgid % nig) / gsz; u.ks = 0; return true;
    }
};
struct OneUnit { int pm, pn; __device__ bool next(int i, Unit& u) const { u.pm = pm; u.pn = pn; u.ks = 0; return i == 0; } };
template <class Epi, class Sched>
__device__ __forceinline__ void gemm_phase(LAS unsigned char* lds, const Gemm g, const Sched& S, const Epi& E) {
    const int tid = opaque_tid(), wid = __builtin_amdgcn_readfirstlane(tid >> 6), lane = tid & 63, wr = wid >> 2, wc = wid & 3, fr = lane & 15, fq = lane >> 4;
    const int K = g.K, nt = K / BK;
    unsigned voffA[2], voffB[2];
#pragma unroll
    for (int i = 0; i < 2; ++i) { int R, C; stage_rc(tid * 16 + i * 8192, R, C); const int Rb = (R & ~31) + perm32(R & 31);
        voffA[i] = (unsigned)(R * g.ld + C) * 2u; voffB[i] = (unsigned)(Rb * g.ld + C) * 2u; }
    const size_t kstep = (size_t)(BK * 2);
    const size_t hstep = (size_t)HALF * g.ld * 2;
    const size_t tstep = 2 * hstep;
    const unsigned ldsw = (unsigned)wid * 1024u;
    const int aoff = lds_byte(wr * 64 + fr, fq * 8), boff = lds_byte(wc * 32 + fr, fq * 8);
#define PG8_SA(b, h) (((b) * 2 + (h)) * HTB)
#define PG8_SB(b, h) ((4 + (b) * 2 + (h)) * HTB)
#define PG8_STAGE(bufoff, gbase, voff) do { _Pragma("unroll") for (int _i = 0; _i < 2; ++_i) \
        __builtin_amdgcn_global_load_lds((const unsigned*)((const char*)(gbase) + (voff)[_i]), (LAS unsigned*)(lds + (bufoff) + ldsw + _i * 8192), 16, 0, 0); } while (0)
#define PG8_LDA(dst, b, h) do { _Pragma("unroll") for (int m = 0; m < 4; ++m) _Pragma("unroll") for (int k = 0; k < 2; ++k) dst[m][k] = *(const LAS bf16x8*)(lds + PG8_SA(b, h) + aoff + m * 2048 + k * 1024); } while (0)
#define PG8_LDB(dst, b, h) do { _Pragma("unroll") for (int n = 0; n < 2; ++n) _Pragma("unroll") for (int k = 0; k < 2; ++k) dst[n][k] = *(const LAS bf16x8*)(lds + PG8_SB(b, h) + boff + n * 2048 + k * 1024); } while (0)
#define PG8_MMA(ai, bj, At, Bt) do { __builtin_amdgcn_s_setprio(1); _Pragma("unroll") for (int m = 0; m < 4; ++m) _Pragma("unroll") for (int n = 0; n < 2; ++n) _Pragma("unroll") for (int k = 0; k < 2; ++k) \
        acc[ai][bj][m][n] = __builtin_amdgcn_mfma_f32_16x16x32_bf16(Bt[n][k], At[m][k], acc[ai][bj][m][n], 0, 0, 0); __builtin_amdgcn_s_setprio(0); } while (0)
#define PG8_WAIT_V(n) asm volatile("s_waitcnt vmcnt(" #n ")" ::: "memory")
#define PG8_WAIT_L(n) asm volatile("s_waitcnt lgkmcnt(" #n ")" ::: "memory")
#define PG8_BAR __builtin_amdgcn_s_barrier()
#define PG8_SCHED __builtin_amdgcn_sched_barrier(0)
    Unit cur, nxt; int ui = 0;
    if (!S.next(0, cur)) return;
    const int nsp = g.nsplit; const size_t ksb = (size_t)K * 2;
    cur.ks = cur.pn % nsp; cur.pn /= nsp;
    f32x4 acc[2][2][4][2];
#pragma unroll
    for (int a = 0; a < 2; ++a)
#pragma unroll
        for (int b = 0; b < 2; ++b)
#pragma unroll
            for (int m = 0; m < 4; ++m)
#pragma unroll
                for (int n = 0; n < 2; ++n) acc[a][b][m][n] = (f32x4){0.f, 0.f, 0.f, 0.f};
    bf16x8 At[4][2], B0[2][2], B1[2][2];
    const char* cA = (const char*)g.A + (size_t)cur.pm * tstep + cur.ks * ksb; const char* cB = (const char*)g.Bt + (size_t)cur.pn * tstep + cur.ks * ksb;
    PG8_STAGE(PG8_SB(0, 0), cB, voffB); PG8_STAGE(PG8_SA(0, 0), cA, voffA); PG8_STAGE(PG8_SB(0, 1), cB + hstep, voffB); PG8_STAGE(PG8_SA(0, 1), cA + hstep, voffA);
    if (wr == 1) PG8_BAR;
    PG8_WAIT_V(4); PG8_BAR;
    PG8_STAGE(PG8_SB(1, 0), cB + kstep, voffB); PG8_STAGE(PG8_SA(1, 0), cA + kstep, voffA); PG8_STAGE(PG8_SB(1, 1), cB + hstep + kstep, voffB);
    PG8_WAIT_V(6); PG8_BAR;
    for (;;) {
        const bool has_next = S.next(ui + 1, nxt);
        if (has_next) { nxt.ks = nxt.pn % nsp; nxt.pn /= nsp; }
        const char* nA = has_next ? (const char*)g.A + (size_t)nxt.pm * tstep + nxt.ks * ksb : cA; const char* nB = has_next ? (const char*)g.Bt + (size_t)nxt.pn * tstep + nxt.ks * ksb : cB;
        for (int t = 0; t < nt; t += 2) {
            const bool last = (t == nt - 2);
            const char* a1 = cA + (size_t)(t + 1) * kstep;
            const char* a2 = last ? nA : cA + (size_t)(t + 2) * kstep; const char* b2 = last ? nB : cB + (size_t)(t + 2) * kstep;
            const char* a3 = a2 + kstep; const char* b3 = b2 + kstep;
            PG8_LDB(B0, 0, 0); PG8_SCHED; PG8_LDA(At, 0, 0); PG8_STAGE(PG8_SA(1, 1), a1 + hstep, voffA);
            PG8_WAIT_L(8); PG8_BAR; PG8_WAIT_L(0); PG8_MMA(0, 0, At, B0); PG8_BAR; PG8_SCHED;
            PG8_LDB(B1, 0, 1); PG8_STAGE(PG8_SB(0, 0), b2, voffB);
            PG8_BAR; PG8_WAIT_L(0); PG8_MMA(0, 1, At, B1); PG8_BAR;
            PG8_LDA(At, 0, 1); PG8_STAGE(PG8_SA(0, 0), a2, voffA);
            PG8_BAR; PG8_WAIT_L(0); PG8_MMA(1, 0, At, B0); PG8_BAR; PG8_SCHED;
            PG8_STAGE(PG8_SB(0, 1), b2 + hstep, voffB);
            PG8_WAIT_V(6); PG8_BAR; PG8_MMA(1, 1, At, B1); PG8_BAR;
            PG8_LDB(B0, 1, 0); PG8_SCHED; PG8_LDA(At, 1, 0); PG8_STAGE(PG8_SA(0, 1), a2 + hstep, voffA);
            PG8_WAIT_L(8); PG8_BAR; PG8_WAIT_L(0); PG8_MMA(0, 0, At, B0); PG8_BAR; PG8_SCHED;
            PG8_LDB(B1, 1, 1); PG8_STAGE(PG8_SB(1, 0), b3, voffB);
            PG8_BAR; PG8_WAIT_L(0); PG8_MMA(0, 1, At, B1); PG8_BAR;
            PG8_LDA(At, 1, 1); PG8_STAGE(PG8_SA(1, 0), a3, voffA);
            PG8_BAR; PG8_WAIT_L(0); PG8_MMA(1, 0, At, B0); PG8_BAR; PG8_SCHED;
            PG8_STAGE(PG8_SB(1, 1), b3 + hstep, voffB);
            PG8_WAIT_V(6); PG8_BAR; PG8_MMA(1, 1, At, B1); PG8_BAR;
        }
        E(acc, cur, wr, wc, fr, fq);
        if (!has_next) break;
#pragma unroll
        for (int a = 0; a < 2; ++a)
#pragma unroll
            for (int b = 0; b < 2; ++b)
#pragma unroll
                for (int m = 0; m < 4; ++m)
#pragma unroll
                    for (int n = 0; n < 2; ++n) acc[a][b][m][n] = (f32x4){0.f, 0.f, 0.f, 0.f};
        cur = nxt; cA = nA; cB = nB; ++ui;
    }
    PG8_WAIT_V(0);
    if (wr == 0) PG8_BAR;
    PG8_BAR;
#undef PG8_SA
#undef PG8_SB
#undef PG8_STAGE
#undef PG8_LDA
#undef PG8_LDB
#undef PG8_MMA
#undef PG8_WAIT_V
#undef PG8_WAIT_L
#undef PG8_BAR
#undef PG8_SCHED
}
}

template <bool SSP> struct EpiScaleBf16 {
    bf16_t* O; int ldc; const float* rs;
    __device__ __forceinline__ void operator()(const f32x4 (&acc)[2][2][4][2], const pg8::Unit& u, int wr, int wc, int fr, int fq) const {
        const int row0 = u.pm * 256 + wr * 64 + fr, col0 = u.pn * 256 + wc * 32 + 8 * fq;
#pragma unroll
        for (int ai = 0; ai < 2; ++ai)
#pragma unroll
            for (int m = 0; m < 4; ++m) {
                const int row = row0 + ai * 128 + m * 16;
                float s;
                if (SSP) { const f32x4* q = (const f32x4*)(rs + (size_t)row * 32) + 2 * fq;
                    const f32x4 t = q[0] + q[1];
                    float ts = t[0] + t[1] + t[2] + t[3];
                    ts += __shfl_xor(ts, 16); ts += __shfl_xor(ts, 32);
                    s = rsqrtf(ts * (1.f / 2048.f) + EPS); }
                else s = rs[row];
                bf16_t* rowp = O + (size_t)row * ldc + col0;
#pragma unroll
                for (int bj = 0; bj < 2; ++bj) *(u32x4*)(rowp + bj * 128) = pack8(acc[ai][bj][m][0] * s, acc[ai][bj][m][1] * s);
            }
    }
};
struct EpiResid {
    const float* resP; const float* resS; float* Y; bf16_t* Xb; float* ssp; float* P1;
    __device__ __forceinline__ void operator()(const f32x4 (&acc)[2][2][4][2], const pg8::Unit& u, int wr, int wc, int fr, int fq) const {
        const int row0 = u.pm * 256 + wr * 64 + fr, col0 = u.pn * 256 + wc * 32 + 8 * fq;
        if (u.ks != 0) {
#pragma unroll
            for (int ai = 0; ai < 2; ++ai)
#pragma unroll
                for (int m = 0; m < 4; ++m) {
                    float* yp = P1 + (size_t)(row0 + ai * 128 + m * 16) * DM + col0;
#pragma unroll
                    for (int bj = 0; bj < 2; ++bj) { *(f32x4*)(yp + bj * 128) = acc[ai][bj][m][0]; *(f32x4*)(yp + bj * 128 + 4) = acc[ai][bj][m][1]; }
                }
            return;
        }
#pragma unroll
        for (int ai = 0; ai < 2; ++ai) {
            f32x4 r[4][2][2];
#pragma unroll
            for (int m = 0; m < 4; ++m) {
                const int row = row0 + ai * 128 + m * 16;
                const float* res = (row < NPT ? resP + (size_t)row * DM : resS + (size_t)(row - NPT) * DM) + col0;
#pragma unroll
                for (int bj = 0; bj < 2; ++bj) { r[m][bj][0] = *(const f32x4*)(res + bj * 128); r[m][bj][1] = *(const f32x4*)(res + bj * 128 + 4); }
            }
            __builtin_amdgcn_sched_barrier(0);
#pragma unroll
            for (int m = 0; m < 4; ++m) {
                const int row = row0 + ai * 128 + m * 16;
                float* yp = Y + (size_t)row * DM + col0;
                float ss = 0.f;
#pragma unroll
                for (int bj = 0; bj < 2; ++bj) {
                    const f32x4 v0 = acc[ai][bj][m][0] + r[m][bj][0], v1 = acc[ai][bj][m][1] + r[m][bj][1];
                    *(f32x4*)(yp + bj * 128) = v0; *(f32x4*)(yp + bj * 128 + 4) = v1;
                    if (Xb) *(u32x4*)(Xb + (size_t)row * DM + col0 + bj * 128) = pack8(v0, v1);
                    ss += v0[0] * v0[0] + v0[1] * v0[1] + v0[2] * v0[2] + v0[3] * v0[3] + v1[0] * v1[0] + v1[1] * v1[1] + v1[2] * v1[2] + v1[3] * v1[3];
                }
                if (ssp) {
                    ss += __shfl_xor(ss, 16); ss += __shfl_xor(ss, 32);
                    if (fq == 0) ssp[(size_t)row * 32 + u.pn * 4 + wc] = ss;
                }
            }
        }
    }
};

__device__ __forceinline__ void conv_tile(const float* __restrict__ W, int N, int src, const float* __restrict__ gk, bf16_t* __restrict__ dst, int k0) {
    float v[64];
#pragma unroll
    for (int j = 0; j < 64; ++j) v[j] = __builtin_nontemporal_load(W + (size_t)(k0 + j) * N + src);
    if (gk) {
#pragma unroll
        for (int j = 0; j < 64; ++j) v[j] *= gk[k0 + j];
    }
#pragma unroll
    for (int kb = 0; kb < 64; kb += 8) {
        u32x4 a;
        a.x = pk_bf16(v[kb], v[kb + 1]); a.y = pk_bf16(v[kb + 2], v[kb + 3]); a.z = pk_bf16(v[kb + 4], v[kb + 5]); a.w = pk_bf16(v[kb + 6], v[kb + 7]);
        *(u32x4*)(dst + kb) = a;
    }
}

__device__ __forceinline__ void phase0(const Params& p, LAS unsigned char* lds) {
    const int tid = opaque_tid(), wave = tid >> 6, lane = tid & 63, fr = lane & 15, fq = lane >> 4;
    const int G = gridDim.x, GW = G * 8, gw = wave * G + blockIdx.x;
    const float* w_in = p.in[9]; const float* g1 = p.in[8];
    unsigned char* ws = p.ws;
    constexpr int WGS = 4112;
    {
        const int n = tid & 31, kb = tid >> 5;
        const int col = n < 16 ? 4096 + n : 7184 + (n - 16);
#pragma unroll 1
        for (int k0 = 0; k0 < 2048; k0 += 512) {
            float v[32], gg[32];
#pragma unroll
            for (int i = 0; i < 32; ++i) { const int k = k0 + 16 * i + kb; v[i] = n < 24 ? w_in[(size_t)k * PROJ_COLS + col] : 0.f; gg[i] = g1[k]; }
#pragma unroll
            for (int i = 0; i < 32; ++i) { const int k = k0 + 16 * i + kb; *(LAS bf16_t*)(lds + n * WGS + k * 2) = f2bf(v[i] * gg[i]); }
        }
    }
    if (blockIdx.x == 0 && tid == 0) { unsigned* c_ = (unsigned*)(ws + W_CTR); c_[0] = 0u; c_[16] = 0u; c_[32] = 0u; c_[48] = 0u; }
    __syncthreads();
    bf16_t* xb = (bf16_t*)(ws + W_XB); float* rstd1 = (float*)(ws + W_RSTD1); float* gates = (float*)(ws + W_GATES);
    for (int t = gw; t < 576; t += GW) {
        const int R0 = t * 16, row = R0 + fr;
        const float* xr = xrow(p, row);
        f32x4 acc0 = {0.f, 0.f, 0.f, 0.f}, acc1 = {0.f, 0.f, 0.f, 0.f}; float ss = 0.f;
#pragma unroll 2
        for (int kb = 0; kb < 64; kb += 8) {
            f32x4 xa[8], xb4[8];
#pragma unroll
            for (int i = 0; i < 8; ++i) { xa[i] = __builtin_nontemporal_load((const f32x4*)(xr + (kb + i) * 32 + fq * 8)); xb4[i] = __builtin_nontemporal_load((const f32x4*)(xr + (kb + i) * 32 + fq * 8 + 4)); }
#pragma unroll
            for (int i = 0; i < 8; ++i) {
                const int kk = kb + i; const f32x4 a = xa[i], b = xb4[i];
                ss += a[0] * a[0] + a[1] * a[1] + a[2] * a[2] + a[3] * a[3] + b[0] * b[0] + b[1] * b[1] + b[2] * b[2] + b[3] * b[3];
                const u32x4 A = pack8(a, b);
                *(u32x4*)(xb + (size_t)row * DM + kk * 32 + fq * 8) = A;
                const bf16x8 B0 = *(const LAS bf16x8*)(lds + fr * WGS + (kk * 32 + fq * 8) * 2);
                const bf16x8 B1 = *(const LAS bf16x8*)(lds + (16 + fr) * WGS + (kk * 32 + fq * 8) * 2);
                acc0 = __builtin_amdgcn_mfma_f32_16x16x32_bf16(as_bf16x8(A), B0, acc0, 0, 0, 0);
                acc1 = __builtin_amdgcn_mfma_f32_16x16x32_bf16(as_bf16x8(A), B1, acc1, 0, 0, 0);
            }
        }
        ss += __shfl_xor(ss, 16); ss += __shfl_xor(ss, 32);
        const float rs = rsqrtf(ss * (1.f / 2048.f) + EPS);
        if (fq == 0) rstd1[row] = rs;
#pragma unroll
        for (int j = 0; j < 4; ++j) {
            const int m = fq * 4 + j; const float rm = __shfl(rs, m);
            gates[(size_t)(R0 + m) * 32 + fr] = acc0[j] * rm;
            if (fr < 8) gates[(size_t)(R0 + m) * 32 + 16 + fr] = acc1[j] * rm;
        }
    }
    if (gw >= 576 || GW <= 576) {
        const int cw = GW > 576 ? gw - 576 : gw, CW = GW > 576 ? GW - 576 : GW;
        for (int t = cw; t < 4608; t += CW) {
            if (t < 3584) { const int kt = t & 31, ntile = t >> 5, n = ntile * 64 + lane, src = n < 4096 ? n : n + 16;
                conv_tile(w_in, PROJ_COLS, src, g1, (bf16_t*)(ws + W_WIN) + (size_t)n * 2048 + kt * 64, kt * 64); }
            else { const int tt = t - 3584, kt = tt & 31, n = (tt >> 5) * 64 + lane;
                conv_tile(p.in[17], 2048, n, nullptr, (bf16_t*)(ws + W_WOUT) + (size_t)n * 2048 + kt * 64, kt * 64); }
        }
    }
}
__device__ __forceinline__ void convert_late(const Params& p) {
    const int lane = opaque_tid() & 63;
    unsigned char* ws = p.ws;
    unsigned* ctr = (unsigned*)(ws + W_CTR);
    for (;;) {
        unsigned tu = 0;
        if (lane == 0) tu = atomicAdd(ctr, 1u);
        const int t = __builtin_amdgcn_readfirstlane((int)tu);
        if (t >= 5632) break;
        const int kt = t & 31, n = (t >> 5) * 64 + lane;
        conv_tile(p.in[19], FF2, n, p.in[18], (bf16_t*)(ws + W_WUP) + (size_t)n * 2048 + kt * 64, kt * 64);
    }
}
__device__ __forceinline__ void convert_wdown(const Params& p) {
    const int lane = opaque_tid() & 63;
    unsigned char* ws = p.ws;
    unsigned* ctr = (unsigned*)(ws + W_CTR) + 16;
    for (;;) {
        unsigned tu = 0;
        if (lane == 0) tu = atomicAdd(ctr, 1u);
        const int t = __builtin_amdgcn_readfirstlane((int)tu);
        if (t >= 2816) break;
        const int kt = t % 88, n = (t / 88) * 64 + lane;
        conv_tile(p.in[22], 2048, n, nullptr, (bf16_t*)(ws + W_WDOWN) + (size_t)n * FF + kt * 64, kt * 64);
    }
}
__device__ __forceinline__ void signal_done(unsigned* c) {
    asm volatile("s_waitcnt vmcnt(0)" ::: "memory");
    __syncthreads();
    if (threadIdx.x == 0) {
        __builtin_amdgcn_fence(__ATOMIC_RELEASE, "agent");
        asm volatile("s_waitcnt vmcnt(0)" ::: "memory");
        (void)__hip_atomic_fetch_add(c, 1u, __ATOMIC_RELAXED, __HIP_MEMORY_SCOPE_AGENT);
    }
}
__device__ __forceinline__ void wait_count(unsigned* c, unsigned need) {
    if (threadIdx.x == 0) {
        unsigned sp = 0u;
        while (__hip_atomic_load(c, __ATOMIC_RELAXED, __HIP_MEMORY_SCOPE_AGENT) < need) { __builtin_amdgcn_s_sleep(2); if (++sp > (1u << 20)) break; }
        __builtin_amdgcn_fence(__ATOMIC_ACQUIRE, "agent");
        asm volatile("s_waitcnt vmcnt(0)" ::: "memory");
    }
    __syncthreads();
}

__device__ __forceinline__ void phase2(const Params& p, LAS unsigned char* lds) {
    const int tid = opaque_tid(), wave = tid >> 6, lane = tid & 63, fr = lane & 15, fq = lane >> 4;
    unsigned char* ws = p.ws;
    const bf16_t* proj = (const bf16_t*)(ws + W_PROJ); const float* gates = (const float*)(ws + W_GATES);
    const float* convw = p.in[10];
    constexpr int L_Q = 0, L_K = 33792, L_V = 67584, L_QN = 101376, L_KN = 118784, L_SM = 136192, L_A = 0;
    LAS float* s_beta = (LAS float*)(lds + L_SM); LAS float* s_G = s_beta + 64; LAS float* s_eG = s_beta + 128; LAS float* s_ekd = s_beta + 192;
    for (int item = blockIdx.x; item < 1024; item += gridDim.x) {
        const int n = item & 31, h = (item >> 5) & 7, b = item >> 8;
        const int tok0 = b * SEQL + n * 64;
        unsigned char* ib = ws + W_ITEMS + (size_t)item * ITEM_STRIDE;
        if (tid < 384) {
            const int cgp = tid % 48, rr = tid / 48, sec = cgp >> 4, d0 = (cgp & 15) * 8, ch = sec * 1024 + h * 128 + d0;
            float w[4][8];
#pragma unroll
            for (int j = 0; j < 4; ++j) { const f32x4 a = *(const f32x4*)(convw + j * 3072 + ch), c = *(const f32x4*)(convw + j * 3072 + ch + 4);
                w[j][0] = a[0]; w[j][1] = a[1]; w[j][2] = a[2]; w[j][3] = a[3]; w[j][4] = c[0]; w[j][5] = c[1]; w[j][6] = c[2]; w[j][7] = c[3]; }
            u32x4 xw[11];
#pragma unroll
            for (int i = 0; i < 11; ++i) { const int t = n * 64 + rr * 8 - 3 + i;
                xw[i] = t >= 0 ? *(const u32x4*)(proj + (size_t)(tok0 + rr * 8 - 3 + i) * PCOL + ch) : (u32x4){0u, 0u, 0u, 0u}; }
            LAS float* dst = (LAS float*)(lds + (sec == 0 ? L_Q : sec == 1 ? L_K : L_V));
#pragma unroll
            for (int i = 0; i < 8; ++i) {
                float o[8];
#pragma unroll
                for (int e = 0; e < 8; ++e) o[e] = 0.f;
#pragma unroll
                for (int j = 0; j < 4; ++j) { const u32x4 x = xw[i + j];
                    o[0] += w[j][0] * bf_lo(x.x); o[1] += w[j][1] * bf_hi(x.x); o[2] += w[j][2] * bf_lo(x.y); o[3] += w[j][3] * bf_hi(x.y);
                    o[4] += w[j][4] * bf_lo(x.z); o[5] += w[j][5] * bf_hi(x.z); o[6] += w[j][6] * bf_lo(x.w); o[7] += w[j][7] * bf_hi(x.w); }
                LAS float* d = dst + (rr * 8 + i) * 132 + d0;
                *(LAS f32x4*)d = (f32x4){siluf(o[0]), siluf(o[1]), siluf(o[2]), siluf(o[3])};
                *(LAS f32x4*)(d + 4) = (f32x4){siluf(o[4]), siluf(o[5]), siluf(o[6]), siluf(o[7])};
            }
        }
        if (wave == 7) {
            const int row = tok0 + lane;
            const float be = sigm(gates[(size_t)row * 32 + h]);
            const float g = -__expf(p.in[11][h]) * softplusf(gates[(size_t)row * 32 + 8 + h] + p.in[12][h]);
            float Gc = g;
#pragma unroll
            for (int d = 1; d < 64; d <<= 1) { const float t = __shfl_up(Gc, d); if (lane >= d) Gc += t; }
            const float Gl = __shfl(Gc, 63);
            s_beta[lane] = be; s_G[lane] = Gc; s_eG[lane] = __expf(Gc); s_ekd[lane] = __expf(Gl - Gc);
            if (lane == 0) *(float*)(ib + IT_GL) = __expf(Gl);
        }
        __syncthreads();
        {
            const int row = tid >> 2, part = tid & 3, isk = row >> 6, r = row & 63;
            const LAS float* src = (const LAS float*)(lds + (isk ? L_K : L_Q)) + r * 132 + part * 32;
            f32x4 v[8]; float ss = 0.f;
#pragma unroll
            for (int i = 0; i < 8; ++i) { v[i] = *(const LAS f32x4*)(src + i * 4); ss += v[i][0] * v[i][0] + v[i][1] * v[i][1] + v[i][2] * v[i][2] + v[i][3] * v[i][3]; }
            ss += __shfl_xor(ss, 1); ss += __shfl_xor(ss, 2);
            const float rn = rsqrtf(ss + EPS) * (isk ? 1.f : 0.08838834764831845f);
            LAS unsigned char* dst = lds + (isk ? L_KN : L_QN) + r * 272 + part * 64;
#pragma unroll
            for (int i = 0; i < 4; ++i) *(LAS u32x4*)(dst + i * 16) = pack8(v[2 * i] * rn, v[2 * i + 1] * rn);
        }
        __syncthreads();
        {
#pragma unroll
            for (int q = 0; q < 4; ++q) {
                const int tt = wave * 4 + q, which = tt >> 4, it = (tt & 15) >> 2, jt = tt & 3;
                f32x4 acc = {0.f, 0.f, 0.f, 0.f};
                const LAS unsigned char* ap = lds + (which ? L_QN : L_KN) + (16 * it + fr) * 272 + fq * 16;
                const LAS unsigned char* bp = lds + L_KN + (16 * jt + fr) * 272 + fq * 16;
#pragma unroll
                for (int kk = 0; kk < 4; ++kk) acc = __builtin_amdgcn_mfma_f32_16x16x32_bf16(*(const LAS bf16x8*)(ap + kk * 64), *(const LAS bf16x8*)(bp + kk * 64), acc, 0, 0, 0);
                const int j = 16 * jt + fr; const float Gj = s_G[j];
#pragma unroll
                for (int e = 0; e < 4; ++e) {
                    const int i = 16 * it + 4 * fq + e;
                    const float dec = __expf(fminf(s_G[i] - Gj, 0.f));
                    if (which == 0) ((LAS float*)(lds + L_A))[j * 68 + i] = (i > j) ? acc[e] * s_beta[i] * dec : 0.f;
                    else *(bf16_t*)(ib + IT_QK + i * 144 + j * 2) = f2bf((i >= j) ? acc[e] * dec : 0.f);
                }
            }
        }
        __syncthreads();
        if (tid < 256) {
            const LAS float* At = (const LAS float*)(lds + L_A);
            const bool isu = tid < 128; const int col = isu ? tid : tid - 128;
            LAS float* X = (LAS float*)(lds + (isu ? L_V : L_K)) + col;
#pragma unroll 1
            for (int blk = 0; blk < 4; ++blk) {
                float acc[16];
#pragma unroll
                for (int ii = 0; ii < 16; ++ii) { const int i = 16 * blk + ii;
                    acc[ii] = isu ? X[i * 132] * s_beta[i] : bf2f(*(const LAS bf16_t*)(lds + L_KN + i * 272 + col * 2)) * s_beta[i] * s_eG[i]; }
#pragma unroll 4
                for (int j = 0; j < 16 * blk; ++j) {
                    const float xj = X[j * 132];
                    const LAS float* ar = At + j * 68 + 16 * blk;
                    const f32x4 a0 = *(const LAS f32x4*)ar, a1 = *(const LAS f32x4*)(ar + 4), a2 = *(const LAS f32x4*)(ar + 8), a3 = *(const LAS f32x4*)(ar + 12);
#pragma unroll
                    for (int e = 0; e < 4; ++e) { acc[e] -= a0[e] * xj; acc[4 + e] -= a1[e] * xj; acc[8 + e] -= a2[e] * xj; acc[12 + e] -= a3[e] * xj; }
                }
#pragma unroll
                for (int jj = 0; jj < 15; ++jj) {
                    const float xj = acc[jj];
                    const LAS float* ar = At + (16 * blk + jj) * 68 + 16 * blk;
                    const f32x4 a0 = *(const LAS f32x4*)ar, a1 = *(const LAS f32x4*)(ar + 4), a2 = *(const LAS f32x4*)(ar + 8), a3 = *(const LAS f32x4*)(ar + 12);
                    const float av[16] = {a0[0], a0[1], a0[2], a0[3], a1[0], a1[1], a1[2], a1[3], a2[0], a2[1], a2[2], a2[3], a3[0], a3[1], a3[2], a3[3]};
#pragma unroll
                    for (int ii = jj + 1; ii < 16; ++ii) acc[ii] -= av[ii] * xj;
                }
#pragma unroll
                for (int ii = 0; ii < 16; ++ii) X[(16 * blk + ii) * 132] = acc[ii];
            }
            if (isu) {
#pragma unroll 1
                for (int i = 0; i < 8; ++i) { u32x4 w; w.x = pk_bf16(X[(8 * i) * 132], X[(8 * i + 1) * 132]); w.y = pk_bf16(X[(8 * i + 2) * 132], X[(8 * i + 3) * 132]);
                    w.z = pk_bf16(X[(8 * i + 4) * 132], X[(8 * i + 5) * 132]); w.w = pk_bf16(X[(8 * i + 6) * 132], X[(8 * i + 7) * 132]);
                    *(u32x4*)(ib + IT_UT + col * 144 + i * 16) = w; }
            } else {
#pragma unroll 4
                for (int i = 0; i < 64; ++i) *(bf16_t*)(ib + IT_W + i * 272 + col * 2) = f2bf(X[i * 132]);
            }
        } else {
            const int t2 = tid - 256;
            { const int i = t2 >> 2, part = t2 & 3; const float sc = s_eG[i];
#pragma unroll
              for (int q = 0; q < 4; ++q) { const u32x4 v = *(const LAS u32x4*)(lds + L_QN + i * 272 + part * 64 + q * 16); u32x4 w;
                  w.x = pk_bf16(bf_lo(v.x) * sc, bf_hi(v.x) * sc); w.y = pk_bf16(bf_lo(v.y) * sc, bf_hi(v.y) * sc); w.z = pk_bf16(bf_lo(v.z) * sc, bf_hi(v.z) * sc); w.w = pk_bf16(bf_lo(v.w) * sc, bf_hi(v.w) * sc);
                  *(u32x4*)(ib + IT_QE + i * 272 + part * 64 + q * 16) = w; } }
            { const int k = t2 & 127, cg2 = t2 >> 7;
#pragma unroll
              for (int q = 0; q < 4; ++q) { float v[8];
#pragma unroll
                  for (int e = 0; e < 8; ++e) { const int c = cg2 * 32 + q * 8 + e; v[e] = bf2f(*(const LAS bf16_t*)(lds + L_KN + c * 272 + k * 2)) * s_ekd[c]; }
                  u32x4 w; w.x = pk_bf16(v[0], v[1]); w.y = pk_bf16(v[2], v[3]); w.z = pk_bf16(v[4], v[5]); w.w = pk_bf16(v[6], v[7]);
                  *(u32x4*)(ib + IT_KDT + k * 144 + cg2 * 64 + q * 16) = w; } }
        }
        __syncthreads();
    }
    {
        float* out = p.out;
        const int gt = blockIdx.x * 512 + tid, GT = gridDim.x * 512;
        for (int i = gt; i < 128 * 3 * 3072; i += GT) { const int c = i % 3072, j = (i / 3072) % 3, s = i / 9216;
            out[O_S_DNCONV + i] = bf2f(proj[(size_t)(NPT + 8 * s + 5 + j) * PCOL + c]); }
        for (int i = gt; i < 4 * 3 * 3072; i += GT) { const int c = i % 3072, j = (i / 3072) % 3, b = i / 9216;
            out[O_P_DNCONV + i] = bf2f(proj[(size_t)(b * SEQL + 2045 + j) * PCOL + c]); }
    }
}

__device__ __forceinline__ bf16x8 frag2(const LAS unsigned char* p) {
    const u32x2 a = *(const LAS u32x2*)p, b = *(const LAS u32x2*)(p + 32); u32x4 w; w.x = a.x; w.y = a.y; w.z = b.x; w.w = b.y; return as_bf16x8(w);
}
#define MFMA16(A, B, C) __builtin_amdgcn_mfma_f32_16x16x32_bf16((A), (B), (C), 0, 0, 0)

__device__ __forceinline__ void scan_dn(const Params& p, LAS unsigned char* lds, int bh) {
    const int tid = opaque_tid(), wave = tid >> 6, lane = tid & 63, fr = lane & 15, fq = lane >> 4;
    const int b = bh >> 3, h = bh & 7;
    unsigned char* ws = p.ws;
    const bf16_t* proj = (const bf16_t*)(ws + W_PROJ); bf16_t* mix = (bf16_t*)(ws + W_MIX);
    const unsigned char* items = ws + W_ITEMS + (size_t)bh * 32 * ITEM_STRIDE;
    constexpr int L_O = 81920;
    f32x4 S[8];
#pragma unroll
    for (int i = 0; i < 8; ++i) S[i] = (f32x4){0.f, 0.f, 0.f, 0.f};
    u32x4 pf[10];
#pragma unroll
    for (int i = 0; i < 10; ++i) { const int idx = tid + 512 * i; if (idx < ITEM_COPY16) pf[i] = __builtin_nontemporal_load((const u32x4*)(items + (size_t)idx * 16)); }
    const bf16_t* zbase = proj + (size_t)(b * SEQL + (tid >> 3)) * PCOL + PC_DNZ + h * 128 + (tid & 7) * 16;
    u32x4 zc0 = *(const u32x4*)zbase, zc1 = *(const u32x4*)(zbase + 8), zn0 = zc0, zn1 = zc1;
    f32x4 gpv[4];
#pragma unroll
    for (int i = 0; i < 4; ++i) gpv[i] = *(const f32x4*)(p.in[13] + (tid & 7) * 16 + 4 * i);
    for (int n = 0; n < 32; ++n) {
#pragma unroll
        for (int i = 0; i < 10; ++i) { const int idx = tid + 512 * i; if (idx < ITEM_COPY16) *(LAS u32x4*)(lds + idx * 16) = pf[i]; }
        __syncthreads();
        if (n + 1 < 32) {
            const unsigned char* nx = items + (size_t)(n + 1) * ITEM_STRIDE;
#pragma unroll
            for (int i = 0; i < 10; ++i) { const int idx = tid + 512 * i; if (idx < ITEM_COPY16) pf[i] = __builtin_nontemporal_load((const u32x4*)(nx + (size_t)idx * 16)); }
            zn0 = *(const u32x4*)(zbase + (size_t)(n + 1) * 64 * PCOL); zn1 = *(const u32x4*)(zbase + (size_t)(n + 1) * 64 * PCOL + 8);
        }
        const float gl = *(const LAS float*)(lds + IT_GL);
        bf16x8 Bs[4];
#pragma unroll
        for (int kk = 0; kk < 4; ++kk) Bs[kk] = as_bf16x8(pack8(S[2 * kk], S[2 * kk + 1]));
        f32x4 T1[4], T2[4];
#pragma unroll
        for (int mt = 0; mt < 4; ++mt) {
            T1[mt] = (f32x4){0.f, 0.f, 0.f, 0.f}; T2[mt] = (f32x4){0.f, 0.f, 0.f, 0.f};
#pragma unroll
            for (int kk = 0; kk < 4; ++kk) {
                T1[mt] = MFMA16(frag2(lds + IT_W + (16 * mt + fr) * 272 + kk * 64 + fq * 8), Bs[kk], T1[mt]);
                T2[mt] = MFMA16(frag2(lds + IT_QE + (16 * mt + fr) * 272 + kk * 64 + fq * 8), Bs[kk], T2[mt]);
            }
        }
#pragma unroll
        for (int mt = 0; mt < 4; ++mt) {
            const u32x2 uu = *(const LAS u32x2*)(lds + IT_UT + (16 * wave + fr) * 144 + (16 * mt + 4 * fq) * 2);
            T1[mt] = (f32x4){bf_lo(uu.x) - T1[mt][0], bf_hi(uu.x) - T1[mt][1], bf_lo(uu.y) - T1[mt][2], bf_hi(uu.y) - T1[mt][3]};
        }
        bf16x8 Bv[2];
#pragma unroll
        for (int kc = 0; kc < 2; ++kc) Bv[kc] = as_bf16x8(pack8(T1[2 * kc], T1[2 * kc + 1]));
#pragma unroll
        for (int mt = 0; mt < 4; ++mt)
#pragma unroll
            for (int kc = 0; kc < 2; ++kc) T2[mt] = MFMA16(frag2(lds + IT_QK + (16 * mt + fr) * 144 + kc * 64 + fq * 8), Bv[kc], T2[mt]);
#pragma unroll
        for (int mk = 0; mk < 8; ++mk) {
            S[mk] *= gl;
#pragma unroll
            for (int kc = 0; kc < 2; ++kc) S[mk] = MFMA16(frag2(lds + IT_KDT + (16 * mk + fr) * 144 + kc * 64 + fq * 8), Bv[kc], S[mk]);
        }
#pragma unroll
        for (int mt = 0; mt < 4; ++mt)
#pragma unroll
            for (int e = 0; e < 4; ++e) ((LAS float*)(lds + L_O))[(16 * mt + 4 * fq + e) * 132 + 16 * wave + fr] = T2[mt][e];
        __syncthreads();
        {
            const int c = tid >> 3, part = tid & 7, row = b * SEQL + n * 64 + c;
            const LAS float* op = (const LAS float*)(lds + L_O) + c * 132 + part * 16;
            f32x4 v[4]; float ss = 0.f;
#pragma unroll
            for (int i = 0; i < 4; ++i) { v[i] = *(const LAS f32x4*)(op + 4 * i); ss += v[i][0] * v[i][0] + v[i][1] * v[i][1] + v[i][2] * v[i][2] + v[i][3] * v[i][3]; }
            ss += __shfl_xor(ss, 1); ss += __shfl_xor(ss, 2); ss += __shfl_xor(ss, 4);
            const float rn = rsqrtf(ss * (1.f / 128.f) + EPS);
            const u32x4 z0 = zc0, z1 = zc1;
            const float gp[16] = {gpv[0][0], gpv[0][1], gpv[0][2], gpv[0][3], gpv[1][0], gpv[1][1], gpv[1][2], gpv[1][3], gpv[2][0], gpv[2][1], gpv[2][2], gpv[2][3], gpv[3][0], gpv[3][1], gpv[3][2], gpv[3][3]};
            float zz[16] = {bf_lo(z0.x), bf_hi(z0.x), bf_lo(z0.y), bf_hi(z0.y), bf_lo(z0.z), bf_hi(z0.z), bf_lo(z0.w), bf_hi(z0.w),
                            bf_lo(z1.x), bf_hi(z1.x), bf_lo(z1.y), bf_hi(z1.y), bf_lo(z1.z), bf_hi(z1.z), bf_lo(z1.w), bf_hi(z1.w)};
            float o[16];
#pragma unroll
            for (int i = 0; i < 16; ++i) o[i] = v[i >> 2][i & 3] * rn * gp[i] * siluf(zz[i]);
            u32x4 w0, w1;
            w0.x = pk_bf16(o[0], o[1]); w0.y = pk_bf16(o[2], o[3]); w0.z = pk_bf16(o[4], o[5]); w0.w = pk_bf16(o[6], o[7]);
            w1.x = pk_bf16(o[8], o[9]); w1.y = pk_bf16(o[10], o[11]); w1.z = pk_bf16(o[12], o[13]); w1.w = pk_bf16(o[14], o[15]);
            bf16_t* mp = mix + (size_t)row * DM + h * 128 + part * 16;
            *(u32x4*)mp = w0; *(u32x4*)(mp + 8) = w1;
            zc0 = zn0; zc1 = zn1;
        }
    }
    int l2 = tid; asm volatile("" : "+v"(l2));
    float* so = p.out + O_P_DNS + (size_t)bh * 128 * 128 + (size_t)(4 * ((l2 & 63) >> 4)) * 128 + 16 * (l2 >> 6) + (l2 & 15);
#pragma unroll
    for (int mk = 0; mk < 8; ++mk)
#pragma unroll
        for (int e = 0; e < 4; ++e) so[(16 * mk + e) * 128] = S[mk][e];
}

struct MlGate { float bc, av, Mi, M63, b63; };
__device__ __forceinline__ MlGate ml_gates(const float* gates, int tok0, int lane, int h, float fb, float ib, float m_prev) {
    const float fg = logsigm(gates[(size_t)(tok0 + lane) * 32 + 20 + h] + fb), ig = gates[(size_t)(tok0 + lane) * 32 + 16 + h] + ib;
    float bc = fg;
#pragma unroll
    for (int d = 1; d < 64; d <<= 1) { const float t = __shfl_up(bc, d); if (lane >= d) bc += t; }
    const float av = ig - bc;
    float pm = av;
#pragma unroll
    for (int d = 1; d < 64; d <<= 1) { const float t = __shfl_up(pm, d); if (lane >= d) pm = fmaxf(pm, t); }
    MlGate g; g.bc = bc; g.av = av; g.Mi = fmaxf(m_prev, pm); g.M63 = __shfl(g.Mi, 63); g.b63 = __shfl(bc, 63);
    return g;
}

__device__ __forceinline__ void ml_passA(const Params& p, LAS unsigned char* lds, int item) {
    const int tid = opaque_tid(), wave = tid >> 6, lane = tid & 63, fr = lane & 15, fq = lane >> 4;
    const int n = item & 31, bh = item >> 5, h = bh & 3, b = bh >> 2, tok0 = b * SEQL + n * 64;
    unsigned char* ws = p.ws;
    const bf16_t* proj = (const bf16_t*)(ws + W_PROJ); const float* gates = (const float*)(ws + W_GATES);
    constexpr int L_KT = 0, L_VT = 18432, L_RED = 55296;
    LAS float* red = (LAS float*)(lds + L_RED);
    const float ib = p.in[14][h], fb = p.in[15][h];
    float m_prev;
    {
        float fl[4], il[4], lsum = 0.f;
#pragma unroll
        for (int e = 0; e < 4; ++e) { const int sidx = tid * 4 + e; float f = 0.f, iv = -3.0e38f;
            if (sidx < n * 64) { const size_t row = (size_t)(b * SEQL + sidx); f = logsigm(gates[row * 32 + 20 + h] + fb); iv = gates[row * 32 + 16 + h] + ib; }
            lsum += f; fl[e] = lsum; il[e] = iv; }
        float incl = lsum;
#pragma unroll
        for (int d = 1; d < 64; d <<= 1) { const float t = __shfl_up(incl, d); if (lane >= d) incl += t; }
        if (lane == 63) red[wave] = incl;
        __syncthreads();
        float woff = 0.f, ftot = 0.f;
#pragma unroll
        for (int w = 0; w < 8; ++w) { const float r = red[w]; ftot += r; if (w < wave) woff += r; }
        const float excl = woff + incl - lsum;
        float mx = -3.0e38f;
#pragma unroll
        for (int e = 0; e < 4; ++e) mx = fmaxf(mx, il[e] - (excl + fl[e]));
#pragma unroll
        for (int d = 32; d >= 1; d >>= 1) mx = fmaxf(mx, __shfl_xor(mx, d));
        if (lane == 0) red[8 + wave] = mx;
        __syncthreads();
        float gm = 0.f;
#pragma unroll
        for (int w = 0; w < 8; ++w) gm = fmaxf(gm, red[8 + w]);
        m_prev = ftot + gm;
    }
    const MlGate g = ml_gates(gates, tok0, lane, h, fb, ib, m_prev);
    const float wend = __expf(g.av - g.M63), cs = __expf(m_prev - g.M63);
    const int lr = tid >> 3, lp = tid & 7;
    {
        const bf16_t* rp = proj + (size_t)(tok0 + lr) * PCOL;
        const u32x4 pk0 = *(const u32x4*)(rp + PC_MLK + h * 128 + lp * 16), pk1 = *(const u32x4*)(rp + PC_MLK + h * 128 + lp * 16 + 8);
        u32x4 pv[4];
#pragma unroll
        for (int i = 0; i < 4; ++i) pv[i] = *(const u32x4*)(rp + PC_MLV + h * 256 + lp * 32 + i * 8);
        const float we = __shfl(wend, lr & 63);
        const unsigned kw[8] = {pk0.x, pk0.y, pk0.z, pk0.w, pk1.x, pk1.y, pk1.z, pk1.w};
#pragma unroll
        for (int e = 0; e < 8; ++e) {
            *(LAS bf16_t*)(lds + L_KT + (lp * 16 + 2 * e) * 144 + lr * 2) = f2bf(bf_lo(kw[e]) * we);
            *(LAS bf16_t*)(lds + L_KT + (lp * 16 + 2 * e + 1) * 144 + lr * 2) = f2bf(bf_hi(kw[e]) * we);
        }
#pragma unroll
        for (int i = 0; i < 4; ++i) { const unsigned vw[4] = {pv[i].x, pv[i].y, pv[i].z, pv[i].w};
#pragma unroll
            for (int e = 0; e < 4; ++e) {
                *(LAS bf16_t*)(lds + L_VT + (lp * 32 + i * 8 + 2 * e) * 144 + lr * 2) = (bf16_t)(vw[e] & 0xffffu);
                *(LAS bf16_t*)(lds + L_VT + (lp * 32 + i * 8 + 2 * e + 1) * 144 + lr * 2) = (bf16_t)(vw[e] >> 16);
            } }
    }
    __syncthreads();
    {
        bf16x8 Bv[2][2];
#pragma unroll
        for (int kc = 0; kc < 2; ++kc)
#pragma unroll
            for (int nt = 0; nt < 2; ++nt) Bv[kc][nt] = *(const LAS bf16x8*)(lds + L_VT + (32 * wave + 16 * nt + fr) * 144 + kc * 64 + fq * 16);
        unsigned char* kvb = (unsigned char*)p.out + (size_t)item * 65536;
#pragma unroll
        for (int mk = 0; mk < 8; ++mk) {
            f32x4 c0 = {0.f, 0.f, 0.f, 0.f}, c1 = {0.f, 0.f, 0.f, 0.f};
#pragma unroll
            for (int kc = 0; kc < 2; ++kc) { const bf16x8 a = *(const LAS bf16x8*)(lds + L_KT + (16 * mk + fr) * 144 + kc * 64 + fq * 16);
                c0 = MFMA16(a, Bv[kc][0], c0); c1 = MFMA16(a, Bv[kc][1], c1); }
            u32x2 w0, w1; w0.x = pk_bf16(c0[0], c0[1]); w0.y = pk_bf16(c0[2], c0[3]); w1.x = pk_bf16(c1[0], c1[1]); w1.y = pk_bf16(c1[2], c1[3]);
            *(u32x2*)(kvb + ((32 * wave + fr) * 128 + 16 * mk + 4 * fq) * 2) = w0;
            *(u32x2*)(kvb + ((32 * wave + 16 + fr) * 128 + 16 * mk + 4 * fq) * 2) = w1;
        }
        const int kd = tid >> 2, p4 = tid & 3;
        const u32x4 k0 = *(const LAS u32x4*)(lds + L_KT + kd * 144 + p4 * 32), k1 = *(const LAS u32x4*)(lds + L_KT + kd * 144 + p4 * 32 + 16);
        float ks = bf_lo(k0.x) + bf_hi(k0.x) + bf_lo(k0.y) + bf_hi(k0.y) + bf_lo(k0.z) + bf_hi(k0.z) + bf_lo(k0.w) + bf_hi(k0.w)
                 + bf_lo(k1.x) + bf_hi(k1.x) + bf_lo(k1.y) + bf_hi(k1.y) + bf_lo(k1.z) + bf_hi(k1.z) + bf_lo(k1.w) + bf_hi(k1.w);
        ks += __shfl_xor(ks, 1); ks += __shfl_xor(ks, 2);
        if (p4 == 0) ((float*)(ws + W_MLN))[(size_t)item * 128 + kd] = ks;
        if (tid == 0) { float* sc = (float*)(ws + W_MLSC) + (size_t)item * 4; sc[0] = cs; sc[1] = m_prev; sc[2] = g.b63 + g.M63; sc[3] = 0.f; }
    }
    __syncthreads();
}

__device__ __forceinline__ void ml_passB(const Params& p, int wk, int NW) {
    const int tid = opaque_tid();
    unsigned char* ws = p.ws;
    const float* sc = (const float*)(ws + W_MLSC);
    for (int task = wk * 512 + tid; task < 65536; task += NW * 512) {
        const int bh = task >> 12, e0 = (task & 4095) * 8;
        unsigned char* base = (unsigned char*)p.out + (size_t)bh * 32 * 65536 + (size_t)e0 * 2;
        float C[8];
#pragma unroll
        for (int j = 0; j < 8; ++j) C[j] = 0.f;
#pragma unroll 1
        for (int nb = 0; nb < 32; nb += 8) {
            u32x4 kv[8];
#pragma unroll
            for (int i = 0; i < 8; ++i) kv[i] = __builtin_nontemporal_load((const u32x4*)(base + (size_t)(nb + i) * 65536));
#pragma unroll
            for (int i = 0; i < 8; ++i) {
                u32x4 w; w.x = pk_bf16(C[0], C[1]); w.y = pk_bf16(C[2], C[3]); w.z = pk_bf16(C[4], C[5]); w.w = pk_bf16(C[6], C[7]);
                *(u32x4*)(base + (W_MLCS - W_MLKV) + (size_t)(nb + i) * 65536) = w;
                const float cs = sc[(size_t)(bh * 32 + nb + i) * 4];
                C[0] = cs * C[0] + bf_lo(kv[i].x); C[1] = cs * C[1] + bf_hi(kv[i].x); C[2] = cs * C[2] + bf_lo(kv[i].y); C[3] = cs * C[3] + bf_hi(kv[i].y);
                C[4] = cs * C[4] + bf_lo(kv[i].z); C[5] = cs * C[5] + bf_hi(kv[i].z); C[6] = cs * C[6] + bf_lo(kv[i].w); C[7] = cs * C[7] + bf_hi(kv[i].w);
            }
        }
        const int dv = e0 >> 7, k0 = e0 & 127;
        float* co = p.out + O_P_MLC + (size_t)bh * 32768 + (size_t)k0 * 256 + dv;
#pragma unroll
        for (int j = 0; j < 8; ++j) co[j * 256] = C[j];
    }
    for (int task = wk * 512 + tid; task < 2048; task += NW * 512) {
        const int bh = task >> 7, kd = task & 127;
        const float* mn = (const float*)(ws + W_MLN) + (size_t)bh * 32 * 128 + kd;
        float* ms = (float*)(ws + W_MLNS) + (size_t)bh * 32 * 128 + kd;
        float nn = 0.f;
#pragma unroll 1
        for (int n = 0; n < 32; ++n) { const float kn = mn[n * 128]; ms[n * 128] = nn; nn = sc[(size_t)(bh * 32 + n) * 4] * nn + kn; }
        p.out[O_P_MLN + (size_t)bh * 128 + kd] = nn;
        if (kd == 0) p.out[O_P_MLM + bh] = sc[(size_t)(bh * 32 + 31) * 4 + 2];
    }
}

__device__ __forceinline__ void ml_passC(const Params& p, LAS unsigned char* lds, int item) {
    const int tid = opaque_tid(), wave = tid >> 6, lane = tid & 63, fr = lane & 15, fq = lane >> 4;
    const int n = item & 31, bh = item >> 5, h = bh & 3, b = bh >> 2, tok0 = b * SEQL + n * 64;
    unsigned char* ws = p.ws;
    const bf16_t* proj = (const bf16_t*)(ws + W_PROJ); bf16_t* mix = (bf16_t*)(ws + W_MIX); const float* gates = (const float*)(ws + W_GATES);
    constexpr int L_QS = 0, L_KN = 17408, L_VT = 34816, L_S = 71680, L_SM = 80896, L_O = 0;
    LAS float* s_a = (LAS float*)(lds + L_SM); LAS float* s_M = s_a + 64; LAS float* s_int = s_a + 128; LAS float* s_emn = s_a + 192; LAS float* s_hd = s_a + 256;
    const float ib = p.in[14][h], fb = p.in[15][h];
    const float m_prev = ((const float*)(ws + W_MLSC))[(size_t)item * 4 + 1];
    const MlGate g = ml_gates(gates, tok0, lane, h, fb, ib, m_prev);
    if (wave == 0) { s_a[lane] = g.av; s_M[lane] = g.Mi; s_int[lane] = __expf(m_prev - g.Mi) * 0.08838834764831845f; s_emn[lane] = __expf(-(g.bc + g.Mi)); }
    const int lr = tid >> 3, lp = tid & 7;
    u32x4 zpre[4];
#pragma unroll
    for (int i = 0; i < 4; ++i) zpre[i] = *(const u32x4*)(proj + (size_t)(tok0 + (tid >> 3)) * PCOL + PC_MLO + h * 256 + (tid & 7) * 32 + 8 * i);
    {
        const bf16_t* rp = proj + (size_t)(tok0 + lr) * PCOL;
        const u32x4 pq0 = *(const u32x4*)(rp + PC_MLQ + h * 128 + lp * 16), pq1 = *(const u32x4*)(rp + PC_MLQ + h * 128 + lp * 16 + 8);
        const u32x4 pk0 = *(const u32x4*)(rp + PC_MLK + h * 128 + lp * 16), pk1 = *(const u32x4*)(rp + PC_MLK + h * 128 + lp * 16 + 8);
        u32x4 pv[4];
#pragma unroll
        for (int i = 0; i < 4; ++i) pv[i] = *(const u32x4*)(rp + PC_MLV + h * 256 + lp * 32 + i * 8);
        *(LAS u32x4*)(lds + L_QS + lr * 272 + lp * 32) = pq0; *(LAS u32x4*)(lds + L_QS + lr * 272 + lp * 32 + 16) = pq1;
        *(LAS u32x4*)(lds + L_KN + lr * 272 + lp * 32) = pk0; *(LAS u32x4*)(lds + L_KN + lr * 272 + lp * 32 + 16) = pk1;
#pragma unroll
        for (int i = 0; i < 4; ++i) { const unsigned vw[4] = {pv[i].x, pv[i].y, pv[i].z, pv[i].w};
#pragma unroll
            for (int e = 0; e < 4; ++e) {
                *(LAS bf16_t*)(lds + L_VT + (lp * 32 + i * 8 + 2 * e) * 144 + lr * 2) = (bf16_t)(vw[e] & 0xffffu);
                *(LAS bf16_t*)(lds + L_VT + (lp * 32 + i * 8 + 2 * e + 1) * 144 + lr * 2) = (bf16_t)(vw[e] >> 16);
            } }
    }
    __syncthreads();
#pragma unroll
    for (int q = 0; q < 2; ++q) {
        const int tt = wave + 8 * q, it = tt >> 2, jt = tt & 3;
        f32x4 acc = {0.f, 0.f, 0.f, 0.f};
        if (jt <= it) {
#pragma unroll
            for (int kk = 0; kk < 4; ++kk) acc = MFMA16(*(const LAS bf16x8*)(lds + L_QS + (16 * it + fr) * 272 + kk * 64 + fq * 16), *(const LAS bf16x8*)(lds + L_KN + (16 * jt + fr) * 272 + kk * 64 + fq * 16), acc);
        }
        const int j = 16 * jt + fr; const float aj = s_a[j];
#pragma unroll
        for (int e = 0; e < 4; ++e) { const int i = 16 * it + 4 * fq + e;
            const float v = (j <= i) ? acc[e] * 0.08838834764831845f * __expf(fminf(aj - s_M[i], 0.f)) : 0.f;
            *(LAS bf16_t*)(lds + L_S + i * 144 + j * 2) = f2bf(v); }
    }
    f32x4 T[4][2];
#pragma unroll
    for (int mt = 0; mt < 4; ++mt) { T[mt][0] = (f32x4){0.f, 0.f, 0.f, 0.f}; T[mt][1] = (f32x4){0.f, 0.f, 0.f, 0.f}; }
    {
        const unsigned char* cb = (const unsigned char*)p.out + 33554432 + (size_t)item * 65536;
#pragma unroll
        for (int kk = 0; kk < 4; ++kk) {
            const bf16x8 Bc0 = *(const bf16x8*)(cb + ((32 * wave + fr) * 128 + 32 * kk + 8 * fq) * 2), Bc1 = *(const bf16x8*)(cb + ((32 * wave + 16 + fr) * 128 + 32 * kk + 8 * fq) * 2);
#pragma unroll
            for (int mt = 0; mt < 4; ++mt) { const bf16x8 a = *(const LAS bf16x8*)(lds + L_QS + (16 * mt + fr) * 272 + kk * 64 + fq * 16);
                T[mt][0] = MFMA16(a, Bc0, T[mt][0]); T[mt][1] = MFMA16(a, Bc1, T[mt][1]); }
        }
#pragma unroll
        for (int mt = 0; mt < 4; ++mt)
#pragma unroll
            for (int e = 0; e < 4; ++e) { const float sc = s_int[16 * mt + 4 * fq + e]; T[mt][0][e] *= sc; T[mt][1][e] *= sc; }
    }
    __syncthreads();
    {
        const int r = tid >> 3, part = tid & 7;
        float qn = 0.f;
        { const u32x4 q0 = *(const LAS u32x4*)(lds + L_QS + r * 272 + part * 32), q1 = *(const LAS u32x4*)(lds + L_QS + r * 272 + part * 32 + 16);
          const float* np = (const float*)(ws + W_MLNS) + (size_t)item * 128 + part * 16;
          const unsigned qw[8] = {q0.x, q0.y, q0.z, q0.w, q1.x, q1.y, q1.z, q1.w};
#pragma unroll
          for (int e = 0; e < 8; ++e) qn += bf_lo(qw[e]) * np[2 * e] + bf_hi(qw[e]) * np[2 * e + 1]; }
        float rs = 0.f;
        { const u32x4 s0 = *(const LAS u32x4*)(lds + L_S + r * 144 + part * 16);
          rs = bf_lo(s0.x) + bf_hi(s0.x) + bf_lo(s0.y) + bf_hi(s0.y) + bf_lo(s0.z) + bf_hi(s0.z) + bf_lo(s0.w) + bf_hi(s0.w); }
        float den = s_int[r] * qn + rs;
        den += __shfl_xor(den, 1); den += __shfl_xor(den, 2); den += __shfl_xor(den, 4);
        if (part == 0) s_hd[r] = __builtin_amdgcn_rcpf(fmaxf(fabsf(den), s_emn[r]));
    }
    {
        bf16x8 Bv[2][2];
#pragma unroll
        for (int kc = 0; kc < 2; ++kc)
#pragma unroll
            for (int nt = 0; nt < 2; ++nt) Bv[kc][nt] = *(const LAS bf16x8*)(lds + L_VT + (32 * wave + 16 * nt + fr) * 144 + kc * 64 + fq * 16);
#pragma unroll
        for (int mt = 0; mt < 4; ++mt)
#pragma unroll
            for (int kc = 0; kc < 2; ++kc) { const bf16x8 a = *(const LAS bf16x8*)(lds + L_S + (16 * mt + fr) * 144 + kc * 64 + fq * 16);
                T[mt][0] = MFMA16(a, Bv[kc][0], T[mt][0]); T[mt][1] = MFMA16(a, Bv[kc][1], T[mt][1]); }
    }
    __syncthreads();
#pragma unroll
    for (int mt = 0; mt < 4; ++mt)
#pragma unroll
        for (int e = 0; e < 4; ++e) { const int i = 16 * mt + 4 * fq + e; const float hd = s_hd[i];
            ((LAS float*)(lds + L_O))[i * 260 + 32 * wave + fr] = T[mt][0][e] * hd; ((LAS float*)(lds + L_O))[i * 260 + 32 * wave + 16 + fr] = T[mt][1][e] * hd; }
    __syncthreads();
    {
        const int c = tid >> 3, part = tid & 7, row = tok0 + c;
        const LAS float* op = (const LAS float*)(lds + L_O) + c * 260 + part * 32;
        f32x4 v[8]; float ss = 0.f;
#pragma unroll
        for (int i = 0; i < 8; ++i) { v[i] = *(const LAS f32x4*)(op + 4 * i); ss += v[i][0] * v[i][0] + v[i][1] * v[i][1] + v[i][2] * v[i][2] + v[i][3] * v[i][3]; }
        ss += __shfl_xor(ss, 1); ss += __shfl_xor(ss, 2); ss += __shfl_xor(ss, 4);
        const float rn = rsqrtf(ss * (1.f / 256.f) + EPS);
        const bf16_t* zp = proj + (size_t)row * PCOL + PC_MLO + h * 256 + part * 32;
        const float* gp = p.in[16] + h * 256 + part * 32;
        bf16_t* mp = mix + (size_t)row * DM + 1024 + h * 256 + part * 32;
#pragma unroll
        for (int i = 0; i < 4; ++i) {
            const u32x4 z = zpre[i];
            const float zz[8] = {bf_lo(z.x), bf_hi(z.x), bf_lo(z.y), bf_hi(z.y), bf_lo(z.z), bf_hi(z.z), bf_lo(z.w), bf_hi(z.w)};
            float o[8];
#pragma unroll
            for (int e = 0; e < 8; ++e) o[e] = v[2 * i + (e >> 2)][e & 3] * rn * gp[8 * i + e] * sigm(zz[e]);
            u32x4 w; w.x = pk_bf16(o[0], o[1]); w.y = pk_bf16(o[2], o[3]); w.z = pk_bf16(o[4], o[5]); w.w = pk_bf16(o[6], o[7]);
            *(u32x4*)(mp + 8 * i) = w;
        }
    }
    __syncthreads();
}

__device__ __forceinline__ void sample_dn(const Params& p, LAS unsigned char* lds, int iter) {
    const int tid = opaque_tid(), sub = tid >> 7, j = tid & 127, wv = (tid >> 6) & 1, lane = tid & 63;
    const int item = iter * 4 + sub, s = item >> 3, h = item & 7;
    unsigned char* ws = p.ws;
    const bf16_t* proj = (const bf16_t*)(ws + W_PROJ); bf16_t* mix = (bf16_t*)(ws + W_MIX); const float* gates = (const float*)(ws + W_GATES);
    LAS float* sq = (LAS float*)(lds + sub * 24576); LAS float* sk = sq + 1024; LAS float* sv = sq + 2048; LAS float* so = sq + 3072; LAS float* sz = sq + 4096;
    LAS float* red = sq + 5120;   LAS float* sg = sq + 5152;
    const int row0 = NPT + 8 * s;
#pragma unroll
    for (int t = 0; t < 8; ++t) sz[t * 128 + j] = bf2f(proj[(size_t)(row0 + t) * PCOL + PC_DNZ + h * 128 + j]);
    float qv[8], kv[8];
#pragma unroll
    for (int sec = 0; sec < 3; ++sec) {
        const int c = sec * 1024 + h * 128 + j;
        float xp[11];
#pragma unroll
        for (int i = 0; i < 3; ++i) xp[i] = p.in[2][(size_t)(s * 3 + i) * 3072 + c];
#pragma unroll
        for (int t = 0; t < 8; ++t) xp[3 + t] = bf2f(proj[(size_t)(row0 + t) * PCOL + c]);
        const float w0 = p.in[10][c], w1 = p.in[10][3072 + c], w2 = p.in[10][6144 + c], w3 = p.in[10][9216 + c];
#pragma unroll
        for (int t = 0; t < 8; ++t) { const float v = siluf(w0 * xp[t] + w1 * xp[t + 1] + w2 * xp[t + 2] + w3 * xp[t + 3]);
            if (sec == 0) qv[t] = v; else if (sec == 1) kv[t] = v; else sv[t * 128 + j] = v; }
    }
    {
        float ra[8], rb[8];
#pragma unroll
        for (int t = 0; t < 8; ++t) { ra[t] = qv[t] * qv[t]; rb[t] = kv[t] * kv[t]; }
#pragma unroll
        for (int d = 32; d >= 1; d >>= 1) {
#pragma unroll
            for (int t = 0; t < 8; ++t) { ra[t] += __shfl_xor(ra[t], d); rb[t] += __shfl_xor(rb[t], d); }
        }
        if (lane == 0) {
#pragma unroll
            for (int t = 0; t < 8; ++t) { red[wv * 16 + t] = ra[t]; red[wv * 16 + 8 + t] = rb[t]; }
        }
    }
    if (j < 8) { const int row = row0 + j;
        sg[2 * j] = __expf(-__expf(p.in[11][h]) * softplusf(gates[(size_t)row * 32 + 8 + h] + p.in[12][h]));
        sg[2 * j + 1] = sigm(gates[(size_t)row * 32 + h]); }
    __syncthreads();
#pragma unroll
    for (int t = 0; t < 8; ++t) {
        sq[t * 128 + j] = qv[t] * rsqrtf(red[t] + red[16 + t] + EPS) * 0.08838834764831845f;
        sk[t * 128 + j] = kv[t] * rsqrtf(red[8 + t] + red[24 + t] + EPS);
    }
    float S[128];
    const float* sp = p.in[3] + ((size_t)(s * 8 + h) * 128) * 128 + j;
#pragma unroll
    for (int k = 0; k < 128; ++k) S[k] = __builtin_nontemporal_load(sp + (size_t)k * 128);
    __syncthreads();
#pragma unroll 1
    for (int t = 0; t < 8; ++t) {
        const float a = sg[2 * t], be = sg[2 * t + 1], vt = sv[t * 128 + j];
        float kvs = 0.f;
#pragma unroll
        for (int k4 = 0; k4 < 32; ++k4) { const f32x4 kk = *(const LAS f32x4*)(sk + t * 128 + 4 * k4);
            kvs += S[4 * k4] * kk[0] + S[4 * k4 + 1] * kk[1] + S[4 * k4 + 2] * kk[2] + S[4 * k4 + 3] * kk[3];
            if ((k4 & 7) == 7) __builtin_amdgcn_sched_barrier(0); }
        const float delta = be * (vt - a * kvs);
        float o = 0.f;
#pragma unroll
        for (int k4 = 0; k4 < 32; ++k4) { const f32x4 kk = *(const LAS f32x4*)(sk + t * 128 + 4 * k4), qq = *(const LAS f32x4*)(sq + t * 128 + 4 * k4);
#pragma unroll
            for (int e = 0; e < 4; ++e) { S[4 * k4 + e] = a * S[4 * k4 + e] + kk[e] * delta; o += S[4 * k4 + e] * qq[e]; }
            if ((k4 & 3) == 3) __builtin_amdgcn_sched_barrier(0); }
        so[t * 128 + j] = o;
    }
    float* dp = p.out + O_S_DNS + ((size_t)(s * 8 + h) * 128) * 128 + j;
#pragma unroll
    for (int k = 0; k < 128; ++k) __builtin_nontemporal_store(S[k], dp + (size_t)k * 128);
    float ov[8];
    {
        float ra[8];
#pragma unroll
        for (int t = 0; t < 8; ++t) { ov[t] = so[t * 128 + j]; ra[t] = ov[t] * ov[t]; }
#pragma unroll
        for (int d = 32; d >= 1; d >>= 1) {
#pragma unroll
            for (int t = 0; t < 8; ++t) ra[t] += __shfl_xor(ra[t], d);
        }
        if (lane == 0) {
#pragma unroll
            for (int t = 0; t < 8; ++t) red[wv * 16 + t] = ra[t];
        }
    }
    __syncthreads();
    const float gn = p.in[13][j];
#pragma unroll
    for (int t = 0; t < 8; ++t) {
        const float rn = rsqrtf((red[t] + red[16 + t]) * (1.f / 128.f) + EPS);
        mix[(size_t)(row0 + t) * DM + h * 128 + j] = f2bf(ov[t] * rn * gn * siluf(sz[t * 128 + j]));
    }
    __syncthreads();
}

__device__ __forceinline__ void sample_ml(const Params& p, LAS unsigned char* lds, int iter) {
    const int tid = opaque_tid(), sub = tid >> 8, j = tid & 255, wv = (tid >> 6) & 3, lane = tid & 63;
    const int item = iter * 2 + sub, s = item >> 2, h = item & 3;
    unsigned char* ws = p.ws;
    const bf16_t* proj = (const bf16_t*)(ws + W_PROJ); bf16_t* mix = (bf16_t*)(ws + W_MIX); const float* gates = (const float*)(ws + W_GATES);
    LAS float* sq = (LAS float*)(lds + sub * 40960); LAS float* sk = sq + 1024; LAS float* sv = sq + 2048;   LAS float* sh = sq + 4096;
    LAS float* sz = sq + 6144;   LAS float* red = sq + 8192;   LAS float* sgt = sq + 8224;   LAS float* sgr = sq + 8256;
    const int row0 = NPT + 8 * s;
#pragma unroll
    for (int t = 0; t < 8; ++t) sz[t * 256 + j] = bf2f(proj[(size_t)(row0 + t) * PCOL + PC_MLO + h * 256 + j]);
    if (j < 8) { sgr[2 * j] = logsigm(gates[(size_t)(row0 + j) * 32 + 20 + h] + p.in[15][h]); sgr[2 * j + 1] = gates[(size_t)(row0 + j) * 32 + 16 + h] + p.in[14][h]; }
    if (j < 128) {
#pragma unroll
        for (int t = 0; t < 8; ++t) {
            sq[t * 128 + j] = bf2f(proj[(size_t)(row0 + t) * PCOL + PC_MLQ + h * 128 + j]) * 0.08838834764831845f;
            sk[t * 128 + j] = bf2f(proj[(size_t)(row0 + t) * PCOL + PC_MLK + h * 128 + j]);
        }
    }
#pragma unroll
    for (int t = 0; t < 8; ++t) sv[t * 256 + j] = bf2f(proj[(size_t)(row0 + t) * PCOL + PC_MLV + h * 256 + j]);
    float Cc[128];
    const float* cp = p.in[4] + ((size_t)(s * 4 + h) * 128) * 256 + j;
#pragma unroll
    for (int k = 0; k < 128; ++k) Cc[k] = __builtin_nontemporal_load(cp + (size_t)k * 256);
    float nj = 0.f;
    if (j < 128) nj = p.in[5][(size_t)(s * 4 + h) * 128 + j];
    const float m0 = p.in[6][s * 4 + h];
    __syncthreads();
    {
        float pd[8]; float m = m0;
#pragma unroll
        for (int t = 0; t < 8; ++t) {
            const float f = sgr[2 * t], ig = sgr[2 * t + 1];
            const float mn = fmaxf(f + m, ig), fp = __expf(f + m - mn), ip = __expf(ig - mn);
            if (j == 0) { sgt[4 * t] = fp; sgt[4 * t + 1] = ip; sgt[4 * t + 2] = __expf(-mn); sgt[4 * t + 3] = mn; }
            m = mn;
            pd[t] = 0.f;
            if (j < 128) { nj = fp * nj + ip * sk[t * 128 + j]; pd[t] = nj * sq[t * 128 + j]; }
        }
#pragma unroll
        for (int d = 32; d >= 1; d >>= 1) {
#pragma unroll
            for (int t = 0; t < 8; ++t) pd[t] += __shfl_xor(pd[t], d);
        }
        if (lane == 0) {
#pragma unroll
            for (int t = 0; t < 8; ++t) red[wv * 8 + t] = pd[t];
        }
    }
    __syncthreads();
#pragma unroll 1
    for (int t = 0; t < 8; ++t) {
        const float f = sgt[4 * t], iv = sgt[4 * t + 1] * sv[t * 256 + j];
        float num = 0.f;
#pragma unroll
        for (int k4 = 0; k4 < 32; ++k4) { const f32x4 kk = *(const LAS f32x4*)(sk + t * 128 + 4 * k4), qq = *(const LAS f32x4*)(sq + t * 128 + 4 * k4);
#pragma unroll
            for (int e = 0; e < 4; ++e) { Cc[4 * k4 + e] = f * Cc[4 * k4 + e] + kk[e] * iv; num += Cc[4 * k4 + e] * qq[e]; }
            if ((k4 & 3) == 3) __builtin_amdgcn_sched_barrier(0); }
        const float den = red[t] + red[8 + t] + red[16 + t] + red[24 + t];
        sh[t * 256 + j] = num * __builtin_amdgcn_rcpf(fmaxf(fabsf(den), sgt[4 * t + 2]));
    }
    float* dp = p.out + O_S_MLC + ((size_t)(s * 4 + h) * 128) * 256 + j;
#pragma unroll
    for (int k = 0; k < 128; ++k) __builtin_nontemporal_store(Cc[k], dp + (size_t)k * 256);
    if (j < 128) p.out[O_S_MLN + (size_t)(s * 4 + h) * 128 + j] = nj;
    if (j == 0) p.out[O_S_MLM + s * 4 + h] = sgt[31];
    __syncthreads();
    float hv[8];
    {
        float ra[8];
#pragma unroll
        for (int t = 0; t < 8; ++t) { hv[t] = sh[t * 256 + j]; ra[t] = hv[t] * hv[t]; }
#pragma unroll
        for (int d = 32; d >= 1; d >>= 1) {
#pragma unroll
            for (int t = 0; t < 8; ++t) ra[t] += __shfl_xor(ra[t], d);
        }
        if (lane == 0) {
#pragma unroll
            for (int t = 0; t < 8; ++t) red[wv * 8 + t] = ra[t];
        }
    }
    __syncthreads();
    const float gn = p.in[16][h * 256 + j];
#pragma unroll
    for (int t = 0; t < 8; ++t) {
        const float rn = rsqrtf((red[t] + red[8 + t] + red[16 + t] + red[24 + t]) * (1.f / 256.f) + EPS);
        mix[(size_t)(row0 + t) * DM + 1024 + h * 256 + j] = f2bf(hv[t] * rn * gn * sigm(sz[t * 256 + j]));
    }
    __syncthreads();
}

__device__ __forceinline__ void phase6(const Params& p) {
    const int tid = opaque_tid();
    unsigned char* ws = p.ws;
    const bf16_t* u = (const bf16_t*)(ws + W_PROJ); bf16_t* act = (bf16_t*)(ws + W_WIN);
    const float* cw = p.in[20]; const float* cb = p.in[21]; const float* st = p.in[7];
    const int gt = blockIdx.x * 512 + tid, GT = gridDim.x * 512;
    for (int task = gt; task < 144 * 704; task += GT) {
        const int cgp = task % 704, chunk = task / 704, R0 = chunk * 64, c0 = cgp * 8;
        const bool smp = R0 >= NPT;
        f32x4 wg[3][2], wu[3][2], bgv[2], buv[2];
#pragma unroll
        for (int jj = 0; jj < 3; ++jj) { wg[jj][0] = *(const f32x4*)(cw + (size_t)jj * FF2 + c0); wg[jj][1] = *(const f32x4*)(cw + (size_t)jj * FF2 + c0 + 4);
            wu[jj][0] = *(const f32x4*)(cw + (size_t)jj * FF2 + FF + c0); wu[jj][1] = *(const f32x4*)(cw + (size_t)jj * FF2 + FF + c0 + 4); }
        bgv[0] = *(const f32x4*)(cb + c0); bgv[1] = *(const f32x4*)(cb + c0 + 4); buv[0] = *(const f32x4*)(cb + FF + c0); buv[1] = *(const f32x4*)(cb + FF + c0 + 4);
        u32x4 xg[10], xu[10];
        if (!smp && (R0 % SEQL) != 0) {
#pragma unroll
            for (int i = 0; i < 2; ++i) { const bf16_t* rp = u + (size_t)(R0 - 2 + i) * FF2 + c0; xg[i] = *(const u32x4*)rp; xu[i] = *(const u32x4*)(rp + FF); }
        } else {
#pragma unroll
            for (int i = 0; i < 2; ++i) { xg[i] = (u32x4){0u, 0u, 0u, 0u}; xu[i] = (u32x4){0u, 0u, 0u, 0u}; }
        }
#pragma unroll 1
        for (int run = 0; run < 8; ++run) {
            const int row0 = R0 + 8 * run;
#pragma unroll
            for (int i = 2; i < 10; ++i) { const bf16_t* rp = u + (size_t)(row0 - 2 + i) * FF2 + c0; xg[i] = *(const u32x4*)rp; xu[i] = *(const u32x4*)(rp + FF); }
            if (smp) {
#pragma unroll
                for (int i = 0; i < 2; ++i) {
                    const float* sp = st + ((size_t)((row0 - NPT) >> 3) * 2 + i) * FF2 + c0;
                    xg[i] = pack8(*(const f32x4*)sp, *(const f32x4*)(sp + 4)); xu[i] = pack8(*(const f32x4*)(sp + FF), *(const f32x4*)(sp + FF + 4));
                }
            }
#define CVL(v) ((f32x4){bf_lo((v).x), bf_hi((v).x), bf_lo((v).y), bf_hi((v).y)})
#define CVH(v) ((f32x4){bf_lo((v).z), bf_hi((v).z), bf_lo((v).w), bf_hi((v).w)})
            {
                f32x4 ga0 = CVL(xg[0]), ga1 = CVH(xg[0]), gb0 = CVL(xg[1]), gb1 = CVH(xg[1]);
                f32x4 ua0 = CVL(xu[0]), ua1 = CVH(xu[0]), ub0 = CVL(xu[1]), ub1 = CVH(xu[1]);
#pragma unroll
                for (int r = 0; r < 8; ++r) {
                    const f32x4 gc0 = CVL(xg[r + 2]), gc1 = CVH(xg[r + 2]), uc0 = CVL(xu[r + 2]), uc1 = CVH(xu[r + 2]);
                    const f32x4 g0 = bgv[0] + wg[0][0] * ga0 + wg[1][0] * gb0 + wg[2][0] * gc0;
                    const f32x4 g1 = bgv[1] + wg[0][1] * ga1 + wg[1][1] * gb1 + wg[2][1] * gc1;
                    const f32x4 u0 = buv[0] + wu[0][0] * ua0 + wu[1][0] * ub0 + wu[2][0] * uc0;
                    const f32x4 u1 = buv[1] + wu[0][1] * ua1 + wu[1][1] * ub1 + wu[2][1] * uc1;
                    u32x4 w; w.x = pk_bf16(siluf(g0[0]) * u0[0], siluf(g0[1]) * u0[1]); w.y = pk_bf16(siluf(g0[2]) * u0[2], siluf(g0[3]) * u0[3]);
                    w.z = pk_bf16(siluf(g1[0]) * u1[0], siluf(g1[1]) * u1[1]); w.w = pk_bf16(siluf(g1[2]) * u1[2], siluf(g1[3]) * u1[3]);
                    *(u32x4*)(act + (size_t)(row0 + r) * FF + c0) = w;
                    ga0 = gb0; ga1 = gb1; gb0 = gc0; gb1 = gc1; ua0 = ub0; ua1 = ub1; ub0 = uc0; ub1 = uc1;
                }
            }
#undef CVL
#undef CVH
            xg[0] = xg[8]; xg[1] = xg[9]; xu[0] = xu[8]; xu[1] = xu[9];
        }
    }
    float* out = p.out;
    for (int i = gt; i < 128 * 2 * FF2; i += GT) { const int c = i % FF2, j = (i / FF2) & 1, s = i / (2 * FF2);
        out[O_S_FFN + i] = bf2f(u[(size_t)(NPT + 8 * s + 6 + j) * FF2 + c]); }
    for (int i = gt; i < 4 * 2 * FF2; i += GT) { const int c = i % FF2, j = (i / FF2) & 1, b = i / (2 * FF2);
        out[O_P_FFN + i] = bf2f(u[(size_t)(b * SEQL + 2046 + j) * FF2 + c]); }
}

__device__ __forceinline__ void phase8(const Params& p) {
    const int tid = opaque_tid(), wave = tid >> 6, lane = tid & 63;
    const float* p1 = (const float*)(p.ws + W_PROJ); const float* g = p.in[23];
    float* y = p.out + O_Y;
    for (int row = blockIdx.x * 8 + wave; row < NTOK; row += gridDim.x * 8) {
        float* yr = y + (size_t)row * DM; const float* pr = p1 + (size_t)row * DM;
        f32x4 v[8]; float ss = 0.f;
#pragma unroll
        for (int i = 0; i < 8; ++i) { const int c = i * 256 + lane * 4; v[i] = *(const f32x4*)(yr + c) + *(const f32x4*)(pr + c);
            ss += v[i][0] * v[i][0] + v[i][1] * v[i][1] + v[i][2] * v[i][2] + v[i][3] * v[i][3]; }
        ss = wave_sum(ss);
        const float rn = rsqrtf(ss * (1.f / 2048.f) + EPS);
#pragma unroll
        for (int i = 0; i < 8; ++i) { const int c = i * 256 + lane * 4; const f32x4 gg = *(const f32x4*)(g + c);
            __builtin_nontemporal_store((f32x4){v[i][0] * rn * gg[0], v[i][1] * rn * gg[1], v[i][2] * rn * gg[2], v[i][3] * rn * gg[3]}, (f32x4*)(yr + c)); }
    }
}

#define XB_TMO      128
#define XB_XCNT(j)  (256  + 64 * (j))
#define XB_XSUB(j)  (1280 + 64 * (j))
#define XB_XGEN(j)  (2304 + 64 * (j))
#define XB_TOP      3328
#define XB_TOPGEN   3392
#define XCD_BAR_WORDS 3456
#define XB_SPIN_CAP (1u << 18)

__device__ __forceinline__ unsigned xb_ld(unsigned* p)              { return __hip_atomic_load(p, __ATOMIC_RELAXED, __HIP_MEMORY_SCOPE_AGENT); }
__device__ __forceinline__ unsigned xb_add(unsigned* p, unsigned v) { return __hip_atomic_fetch_add(p, v, __ATOMIC_RELAXED, __HIP_MEMORY_SCOPE_AGENT); }
__device__ __forceinline__ unsigned xb_xcc_id() { return (unsigned)__builtin_amdgcn_s_getreg((3 << 11) | 20) & 0xFu; }
#define XB_SPIN(cond, bar) do { unsigned _sp = 0; while (cond) { __builtin_amdgcn_s_sleep(1); \
    if ((++_sp & 255u) == 0u) { if (xb_ld(&(bar)[XB_TMO])) break; if (_sp > XB_SPIN_CAP) { atomicAdd(&(bar)[XB_TMO], 1u); break; } } } } while (0)

struct XcdBarrier {
    unsigned* bar; unsigned x;
    volatile LAS unsigned* st;
};

__device__ __forceinline__ XcdBarrier xcd_barrier_post(unsigned* bar, volatile LAS unsigned* st) {
    XcdBarrier b; b.bar = bar; b.x = xb_xcc_id(); b.st = st;
    if (threadIdx.x == 0) (void)xb_add(&bar[XB_XCNT(b.x)], 1u);
    return b;
}
__device__ __forceinline__ void xcd_barrier_complete(unsigned* bar, unsigned x, unsigned& nloc, unsigned& nx) {
    const unsigned G = gridDim.x * gridDim.y * gridDim.z;
    unsigned sum, cnt, mine, sp = 0u;
    for (;;) {
        sum = 0u; cnt = 0u; mine = 0u;
#pragma unroll
        for (unsigned j = 0; j < 16; ++j) { const unsigned c = xb_ld(&bar[XB_XCNT(j)]); sum += c; cnt += (c > 0u) ? 1u : 0u; mine = (j == x) ? c : mine; }
        if (sum == G) break;
        __builtin_amdgcn_s_sleep(1);
        if ((++sp & 255u) == 0u) { if (xb_ld(&bar[XB_TMO])) break; if (sp > XB_SPIN_CAP) { atomicAdd(&bar[XB_TMO], 1u); break; } }
    }
    nloc = mine > 0u ? mine : 1u; nx = cnt > 0u ? cnt : 1u;
}

__device__ __forceinline__ void xcd_barrier(const XcdBarrier& b) {
    asm volatile("s_waitcnt vmcnt(0)" ::: "memory");
    __syncthreads();
    if (threadIdx.x == 0) {
        unsigned* bar = b.bar;
        __builtin_amdgcn_s_waitcnt(0);
        unsigned nloc = b.st[0], nx = b.st[1];
        if (nloc == 0u) { xcd_barrier_complete(bar, b.x, nloc, nx); b.st[0] = nloc; b.st[1] = nx; }
        const unsigned old = xb_add(&bar[XB_XSUB(b.x)], 1u);
        const unsigned gen = old / nloc;
        if (old + 1u == (gen + 1u) * nloc) {
            __builtin_amdgcn_fence(__ATOMIC_RELEASE, "agent");
            asm volatile("s_waitcnt vmcnt(0)" ::: "memory");
            const unsigned og = xb_add(&bar[XB_TOP], 1u);
            const unsigned tg = og / nx;
            if (og + 1u == (tg + 1u) * nx) xb_add(&bar[XB_TOPGEN], 1u);
            else XB_SPIN(xb_ld(&bar[XB_TOPGEN]) == tg, bar);
            __builtin_amdgcn_fence(__ATOMIC_ACQUIRE, "agent");
            xb_add(&bar[XB_XGEN(b.x)], 1u);
            asm volatile("s_waitcnt vmcnt(0)" ::: "memory");
        } else {
            XB_SPIN(xb_ld(&bar[XB_XGEN(b.x)]) == gen, bar);
            __builtin_amdgcn_fence(__ATOMIC_ACQUIRE, "agent");
            asm volatile("s_waitcnt vmcnt(0)" ::: "memory");
        }
    }
    __syncthreads();
}


#define GSYNC() do { asm volatile("s_waitcnt vmcnt(0)" ::: "memory"); grid.sync(); } while (0)
extern __shared__ __attribute__((aligned(16))) unsigned char smem_raw[];

__global__ void __launch_bounds__(512) hymba_fwd(Params p) {
    cg::grid_group grid = cg::this_grid();
    LAS unsigned char* lds = (LAS unsigned char*)smem_raw;
    unsigned char* ws = p.ws;
    pg8::StaticOrder so;
    unsigned* xbar = (unsigned*)(ws + W_BAR);
    volatile LAS unsigned* xst = (volatile LAS unsigned*)(lds + LDS_BYTES - 16);
    if (blockIdx.x == 0) for (int i = threadIdx.x; i < XCD_BAR_WORDS; i += 512) xbar[i] = 0u;
    if (threadIdx.x == 0) { xst[0] = 0u; xst[1] = 0u; }
    __syncthreads();
    GSYNC();
    const XcdBarrier xb = xcd_barrier_post(xbar, xst);
#define XSYNC() xcd_barrier(xb)
    phase0(p, lds);
    XSYNC();
    for (int rep = 0; rep <= DUP_P1; ++rep) {
        so.init(NTOK, PCOL, gridDim.x, blockIdx.x);
        pg8::Gemm g{(const bf16_t*)(ws + W_XB), (const bf16_t*)(ws + W_WIN), NTOK, PCOL, DM, DM, 1};
        EpiScaleBf16<false> e{(bf16_t*)(ws + W_PROJ), PCOL, (const float*)(ws + W_RSTD1)};
        pg8::gemm_phase(lds, g, so, e);
    XSYNC();
    }
    for (int rep = 0; rep <= DUP_P2; ++rep) {
    phase2(p, lds);
    for (int item = blockIdx.x; item < 512; item += gridDim.x) ml_passA(p, lds, item);
    XSYNC();
    }
    {
        const int blk = blockIdx.x;
        unsigned* cdone = (unsigned*)(ws + W_CTR);
        if (blk < 32) scan_dn(p, lds, blk);
        else {
            const int wk = blk - 32, NW = gridDim.x - 32;
            const int npb = NW < 128 ? NW : 128;
            ml_passB(p, wk, NW);
            if (wk < npb) signal_done(cdone + 32);
            for (int it = wk; it < 512; it += NW) { if (it < 256) sample_dn(p, lds, it); else sample_ml(p, lds, it - 256); }
            signal_done(cdone + 48);
            wait_count(cdone + 32, (unsigned)npb);
            for (int item = wk; item < 512; item += NW) ml_passC(p, lds, item);
            if (wk >= 64 && wk < 96) {
                wait_count(cdone + 48, (unsigned)NW);
                pg8::OneUnit ou{32 + ((wk - 64) >> 3), (wk - 64) & 7};
                pg8::Gemm g{(const bf16_t*)(ws + W_MIX), (const bf16_t*)(ws + W_WOUT), NTOK, DM, DM, DM, 1};
                EpiResid e{p.in[0], p.in[1], p.out + O_Y, (bf16_t*)(ws + W_XB), (float*)(ws + W_SSP2), nullptr};
                pg8::gemm_phase(lds, g, ou, e);
            }
        }
        convert_late(p);
    }
    XSYNC();
    {
        so.init(NPT, DM, gridDim.x, blockIdx.x);
        pg8::Gemm g{(const bf16_t*)(ws + W_MIX), (const bf16_t*)(ws + W_WOUT), NPT, DM, DM, DM, 1};
        EpiResid e{p.in[0], p.in[1], p.out + O_Y, (bf16_t*)(ws + W_XB), (float*)(ws + W_SSP2), nullptr};
        pg8::gemm_phase(lds, g, so, e);
    }
    XSYNC();
    for (int rep = 0; rep <= DUP_P5; ++rep) {
        so.init(NTOK, FF2, gridDim.x, blockIdx.x);
        pg8::Gemm g{(const bf16_t*)(ws + W_XB), (const bf16_t*)(ws + W_WUP), NTOK, FF2, DM, DM, 1};
        EpiScaleBf16<true> e{(bf16_t*)(ws + W_PROJ), FF2, (const float*)(ws + W_SSP2)};
        pg8::gemm_phase(lds, g, so, e);
        convert_wdown(p);
    XSYNC();
    }
    for (int rep = 0; rep <= DUP_P6; ++rep) {
    phase6(p);
    XSYNC();
    }
    {
        so.init(NTOK, 2 * DM, gridDim.x, blockIdx.x);
        pg8::Gemm g{(const bf16_t*)(ws + W_WIN), (const bf16_t*)(ws + W_WDOWN), NTOK, DM, FF / 2, FF, 2};
        EpiResid e{p.out + O_Y, p.out + O_Y + (size_t)NPT * DM, p.out + O_Y, nullptr, nullptr, (float*)(ws + W_PROJ)};
        pg8::gemm_phase(lds, g, so, e);
    }
    XSYNC();
    phase8(p);
}

extern "C" void kernel_launch(void* const* d_in, const int* in_sizes, int n_in, void* d_out, int out_size, void* d_ws, size_t ws_size, hipStream_t stream) {
    static int grid_blocks = 0;
    if (grid_blocks == 0) {
        if (n_in != 24 || (size_t)out_size != O_TOTAL || ws_size < W_END2) { fprintf(stderr, "kernel_launch: unexpected shapes (n_in %d out %d ws %zu need %zu)\n", n_in, out_size, ws_size, (size_t)W_END2); grid_blocks = -1; return; }
        int dev = 0, cus = 0, per_cu = 0;
        hipGetDevice(&dev);
        hipDeviceGetAttribute(&cus, hipDeviceAttributeMultiprocessorCount, dev);
        if (hipFuncSetAttribute((const void*)hymba_fwd, hipFuncAttributeMaxDynamicSharedMemorySize, LDS_BYTES) != hipSuccess) { fprintf(stderr, "hipFuncSetAttribute failed\n"); grid_blocks = -1; return; }
        if (hipOccupancyMaxActiveBlocksPerMultiprocessor(&per_cu, (const void*)hymba_fwd, 512, LDS_BYTES) != hipSuccess || per_cu < 1) { fprintf(stderr, "occupancy query failed\n"); grid_blocks = -1; return; }
        grid_blocks = cus * (per_cu > 1 ? 1 : per_cu);
    }
    if (grid_blocks < 0) return;
    Params p{};
    for (int i = 0; i < 24; ++i) p.in[i] = (const float*)d_in[i];
    p.out = (float*)d_out; p.ws = (unsigned char*)d_ws;
    void* args[] = {&p};
    hipError_t e = hipLaunchCooperativeKernel((const void*)hymba_fwd, dim3(grid_blocks), dim3(512), args, LDS_BYTES, stream);
    if (e != hipSuccess) fprintf(stderr, "cooperative launch failed: %s (grid %d)\n", hipGetErrorString(e), grid_blocks);
}
```

```cpp
#include <hip/hip_runtime.h>
#include <hip/hip_cooperative_groups.h>
#include <cstdio>
namespace cg = cooperative_groups;

#define LAS __attribute__((address_space(3)))
typedef unsigned short bf16_t;
typedef short bf16x8 __attribute__((ext_vector_type(8)));
typedef float f32x4 __attribute__((ext_vector_type(4)));
typedef unsigned u32x4 __attribute__((ext_vector_type(4)));
typedef unsigned u32x2 __attribute__((ext_vector_type(2)));

constexpr int DM = 2048, NTOK = 9216, NPT = 8192, SEQL = 2048;
constexpr int PCOL = 7168, PROJ_COLS = 7192, FF = 5632, FF2 = 11264;
constexpr int PC_DNZ = 3072, PC_MLQ = 4096, PC_MLK = 4608, PC_MLV = 5120, PC_MLO = 6144;
constexpr float EPS = 1e-6f;
constexpr int LDS_BYTES = 139264;
#ifndef DUP_P0
#define DUP_P0 0
#endif
#ifndef DUP_P1
#define DUP_P1 0
#endif
#ifndef DUP_P2
#define DUP_P2 0
#endif
#ifndef DUP_P3
#define DUP_P3 0
#endif
#ifndef DUP_P5
#define DUP_P5 0
#endif
#ifndef DUP_P6
#define DUP_P6 0
#endif

constexpr size_t O_Y = 0;
constexpr size_t O_P_DNCONV = 18874368;
constexpr size_t O_P_DNS = O_P_DNCONV + 36864;
constexpr size_t O_P_MLC = O_P_DNS + 524288;
constexpr size_t O_P_MLN = O_P_MLC + 524288;
constexpr size_t O_P_MLM = O_P_MLN + 2048;
constexpr size_t O_P_FFN = O_P_MLM + 16;
constexpr size_t O_S_DNCONV = O_P_FFN + 90112;
constexpr size_t O_S_DNS = O_S_DNCONV + 1179648;
constexpr size_t O_S_MLC = O_S_DNS + 16777216;
constexpr size_t O_S_MLN = O_S_MLC + 16777216;
constexpr size_t O_S_MLM = O_S_MLN + 65536;
constexpr size_t O_S_FFN = O_S_MLM + 512;
constexpr size_t O_TOTAL = O_S_FFN + 2883584;

constexpr size_t W_PROJ = 0;
constexpr size_t W_ITEMS = 132120576;
constexpr size_t W_WIN = 216006656;
constexpr size_t W_XB = W_WIN + 29360128;
constexpr size_t W_MIX = W_XB + 37748736;
constexpr size_t W_WOUT = W_MIX + 37748736;
constexpr size_t W_WUP = W_WOUT + 8388608;
constexpr size_t W_WDOWN = W_WUP + 46137344;
constexpr size_t W_RSTD1 = W_WDOWN + 23068672;
constexpr size_t W_GATES = W_RSTD1 + 36864;
constexpr size_t W_SSP2 = W_GATES + 1179648;
constexpr size_t W_SSP3 = W_SSP2 + 1179648;
constexpr size_t W_END = W_SSP3 + 1179648;
constexpr size_t W_MLKV = W_WIN;
constexpr size_t W_MLCS = W_WIN + 33554432;
constexpr size_t W_MLN = W_SSP3 + 1179648;
constexpr size_t W_MLNS = W_MLN + 262144;
constexpr size_t W_MLSC = W_MLNS + 262144;
constexpr size_t W_CTR = W_MLSC + 8192;
constexpr size_t W_BAR = W_CTR + 256;
constexpr size_t W_END2 = W_BAR + 16384;
constexpr int ITEM_STRIDE = 81920, IT_W = 0, IT_QE = 17408, IT_QK = 34816, IT_KDT = 44032, IT_UT = 62464, IT_GL = 80896, ITEM_COPY16 = 5057;

struct Params { const float* in[24]; float* out; unsigned char* ws; };

typedef __bf16 bf16x2_t __attribute__((ext_vector_type(2)));
typedef float f32x2_t __attribute__((ext_vector_type(2)));
__device__ __forceinline__ unsigned pk_bf16(float lo, float hi) { const f32x2_t v = {lo, hi}; const bf16x2_t r = __builtin_convertvector(v, bf16x2_t); return __builtin_bit_cast(unsigned, r); }
__device__ __forceinline__ float bf_lo(unsigned u) { return __uint_as_float(u << 16); }
__device__ __forceinline__ float bf_hi(unsigned u) { return __uint_as_float(u & 0xffff0000u); }
__device__ __forceinline__ float bf2f(bf16_t b) { return __uint_as_float(((unsigned)b) << 16); }
__device__ __forceinline__ bf16_t f2bf(float f) { return (bf16_t)(pk_bf16(f, 0.f) & 0xffffu); }
__device__ __forceinline__ float siluf(float x) { return x * __builtin_amdgcn_rcpf(1.f + __expf(-x)); }
__device__ __forceinline__ float sigm(float x) { return __builtin_amdgcn_rcpf(1.f + __expf(-x)); }
__device__ __forceinline__ float softplusf(float x) { return x > 20.f ? x : log1pf(__expf(x)); }
__device__ __forceinline__ float logsigm(float x) { return fminf(x, 0.f) - log1pf(__expf(-fabsf(x))); }
__device__ __forceinline__ u32x4 pack8(const f32x4 a, const f32x4 b) { u32x4 w; w.x = pk_bf16(a[0], a[1]); w.y = pk_bf16(a[2], a[3]); w.z = pk_bf16(b[0], b[1]); w.w = pk_bf16(b[2], b[3]); return w; }
__device__ __forceinline__ bf16x8 as_bf16x8(u32x4 w) { return __builtin_bit_cast(bf16x8, w); }
__device__ __forceinline__ int opaque_tid() { int t = threadIdx.x; asm volatile("" : "+v"(t)); return t; }
__device__ __forceinline__ float wave_sum(float v) {
#pragma unroll
    for (int d = 32; d >= 1; d >>= 1) v += __shfl_xor(v, d);
    return v;
}
__device__ __forceinline__ const float* xrow(const Params& p, int row) { return row < NPT ? p.in[0] + (size_t)row * DM : p.in[1] + (size_t)(row - NPT) * DM; }

namespace pg8 {
constexpr int BM = 256, BK = 64, HALF = 128, HTB = HALF * BK * 2, STAGE_BYTES = 8 * HTB, NXCD = 8, WGM = 8;
__device__ __forceinline__ int lds_byte(int r, int c) { const int st = (r >> 4) * 2 + (c >> 5), rr = r & 15, cc = c & 31, ob = rr * 64 + cc * 2; return st * 1024 + (ob ^ (((ob >> 9) & 1) << 5)); }
__device__ __forceinline__ void stage_rc(int b, int& R, int& C) { const int st = b / 1024, sb = b % 1024, swz = sb ^ (((sb >> 9) & 1) << 5); R = (st >> 1) * 16 + swz / 64; C = (st & 1) * 32 + (swz % 64) / 2; }
__device__ __forceinline__ int perm32(int rho) { const int n = rho >> 4, i = rho & 15; return 8 * (i >> 2) + 4 * n + (i & 3); }
struct Unit { int pm, pn, ks; };
struct Gemm { const bf16_t* A; const bf16_t* Bt; int M, N, K, ld, nsplit; };
struct StaticOrder {
    int nM, nN, nwg, G, c;
    __device__ void init(int M, int N, int G_, int c_) { nM = M / BM; nN = N / BM; nwg = nM * nN; G = G_; c = c_; }
    __device__ bool next(int i, Unit& u) const {
        const long L = (long)i * G + c; if (L >= nwg) return false;
        int wgid = (int)L; { const int q = nwg / NXCD, r = nwg % NXCD, xcd = wgid % NXCD, off = wgid / NXCD; wgid = (xcd < r ? xcd * (q + 1) : r * (q + 1) + (xcd - r) * q) + off; }
        const int nig = WGM * nN, gid = wgid / nig, fm = gid * WGM, gsz = (nM - fm) < WGM ? (nM - fm) : WGM;
        u.pm = fm + ((wgid % nig) % gsz); u.pn = (wgid % nig) / gsz; u.ks = 0; return true;
    }
};
struct OneUnit { int pm, pn; __device__ bool next(int i, Unit& u) const { u.pm = pm; u.pn = pn; u.ks = 0; return i == 0; } };
template <class Epi, class Sched>
__device__ __forceinline__ void gemm_phase(LAS unsigned char* lds, const Gemm g, const Sched& S, const Epi& E) {
    const int tid = opaque_tid(), wid = __builtin_amdgcn_readfirstlane(tid >> 6), lane = tid & 63, wr = wid >> 2, wc = wid & 3, fr = lane & 15, fq = lane >> 4;
    const int K = g.K, nt = K / BK;
    unsigned voffA[2], voffB[2];
#pragma unroll
    for (int i = 0; i < 2; ++i) { int R, C; stage_rc(tid * 16 + i * 8192, R, C); const int Rb = (R & ~31) + perm32(R & 31);
        voffA[i] = (unsigned)(R * g.ld + C) * 2u; voffB[i] = (unsigned)(Rb * g.ld + C) * 2u; }
    const size_t kstep = (size_t)(BK * 2);
    const size_t hstep = (size_t)HALF * g.ld * 2;
    const size_t tstep = 2 * hstep;
    const unsigned ldsw = (unsigned)wid * 1024u;
    const int aoff = lds_byte(wr * 64 + fr, fq * 8), boff = lds_byte(wc * 32 + fr, fq * 8);
#define PG8_SA(b, h) (((b) * 2 + (h)) * HTB)
#define PG8_SB(b, h) ((4 + (b) * 2 + (h)) * HTB)
#define PG8_STAGE(bufoff, gbase, voff) do { _Pragma("unroll") for (int _i = 0; _i < 2; ++_i) \
        __builtin_amdgcn_global_load_lds((const unsigned*)((const char*)(gbase) + (voff)[_i]), (LAS unsigned*)(lds + (bufoff) + ldsw + _i * 8192), 16, 0, 0); } while (0)
#define PG8_LDA(dst, b, h) do { _Pragma("unroll") for (int m = 0; m < 4; ++m) _Pragma("unroll") for (int k = 0; k < 2; ++k) dst[m][k] = *(const LAS bf16x8*)(lds + PG8_SA(b, h) + aoff + m * 2048 + k * 1024); } while (0)
#define PG8_LDB(dst, b, h) do { _Pragma("unroll") for (int n = 0; n < 2; ++n) _Pragma("unroll") for (int k = 0; k < 2; ++k) dst[n][k] = *(const LAS bf16x8*)(lds + PG8_SB(b, h) + boff + n * 2048 + k * 1024); } while (0)
#define PG8_MMA(ai, bj, At, Bt) do { __builtin_amdgcn_s_setprio(1); _Pragma("unroll") for (int m = 0; m < 4; ++m) _Pragma("unroll") for (int n = 0; n < 2; ++n) _Pragma("unroll") for (int k = 0; k < 2; ++k) \
        acc[ai][bj][m][n] = __builtin_amdgcn_mfma_f32_16x16x32_bf16(Bt[n][k], At[m][k], acc[ai][bj][m][n], 0, 0, 0); __builtin_amdgcn_s_setprio(0); } while (0)
#define PG8_WAIT_V(n) asm volatile("s_waitcnt vmcnt(" #n ")" ::: "memory")
#define PG8_WAIT_L(n) asm volatile("s_waitcnt lgkmcnt(" #n ")" ::: "memory")
#define PG8_BAR __builtin_amdgcn_s_barrier()
#define PG8_SCHED __builtin_amdgcn_sched_barrier(0)
    Unit cur, nxt; int ui = 0;
    if (!S.next(0, cur)) return;
    const int nsp = g.nsplit; const size_t ksb = (size_t)K * 2;
    cur.ks = cur.pn % nsp; cur.pn /= nsp;
    f32x4 acc[2][2][4][2];
#pragma unroll
    for (int a = 0; a < 2; ++a)
#pragma unroll
        for (int b = 0; b < 2; ++b)
#pragma unroll
            for (int m = 0; m < 4; ++m)
#pragma unroll
                for (int n = 0; n < 2; ++n) acc[a][b][m][n] = (f32x4){0.f, 0.f, 0.f, 0.f};
    bf16x8 At[4][2], B0[2][2], B1[2][2];
    const char* cA = (const char*)g.A + (size_t)cur.pm * tstep + cur.ks * ksb; const char* cB = (const char*)g.Bt + (size_t)cur.pn * tstep + cur.ks * ksb;
    PG8_STAGE(PG8_SB(0, 0), cB, voffB); PG8_STAGE(PG8_SA(0, 0), cA, voffA); PG8_STAGE(PG8_SB(0, 1), cB + hstep, voffB); PG8_STAGE(PG8_SA(0, 1), cA + hstep, voffA);
    if (wr == 1) PG8_BAR;
    PG8_WAIT_V(4); PG8_BAR;
    PG8_STAGE(PG8_SB(1, 0), cB + kstep, voffB); PG8_STAGE(PG8_SA(1, 0), cA + kstep, voffA); PG8_STAGE(PG8_SB(1, 1), cB + hstep + kstep, voffB);
    PG8_WAIT_V(6); PG8_BAR;
    for (;;) {
        const bool has_next = S.next(ui + 1, nxt);
        if (has_next) { nxt.ks = nxt.pn % nsp; nxt.pn /= nsp; }
        const char* nA = has_next ? (const char*)g.A + (size_t)nxt.pm * tstep + nxt.ks * ksb : cA; const char* nB = has_next ? (const char*)g.Bt + (size_t)nxt.pn * tstep + nxt.ks * ksb : cB;
        for (int t = 0; t < nt; t += 2) {
            const bool last = (t == nt - 2);
            const char* a1 = cA + (size_t)(t + 1) * kstep;
            const char* a2 = last ? nA : cA + (size_t)(t + 2) * kstep; const char* b2 = last ? nB : cB + (size_t)(t + 2) * kstep;
            const char* a3 = a2 + kstep; const char* b3 = b2 + kstep;
            PG8_LDB(B0, 0, 0); PG8_SCHED; PG8_LDA(At, 0, 0); PG8_STAGE(PG8_SA(1, 1), a1 + hstep, voffA);
            PG8_WAIT_L(8); PG8_BAR; PG8_WAIT_L(0); PG8_MMA(0, 0, At, B0); PG8_BAR; PG8_SCHED;
            PG8_LDB(B1, 0, 1); PG8_STAGE(PG8_SB(0, 0), b2, voffB);
            PG8_BAR; PG8_WAIT_L(0); PG8_MMA(0, 1, At, B1); PG8_BAR;
            PG8_LDA(At, 0, 1); PG8_STAGE(PG8_SA(0, 0), a2, voffA);
            PG8_BAR; PG8_WAIT_L(0); PG8_MMA(1, 0, At, B0); PG8_BAR; PG8_SCHED;
            PG8_STAGE(PG8_SB(0, 1), b2 + hstep, voffB);
            PG8_WAIT_V(6); PG8_BAR; PG8_MMA(1, 1, At, B1); PG8_BAR;
            PG8_LDB(B0, 1, 0); PG8_SCHED; PG8_LDA(At, 1, 0); PG8_STAGE(PG8_SA(0, 1), a2 + hstep, voffA);
            PG8_WAIT_L(8); PG8_BAR; PG8_WAIT_L(0); PG8_MMA(0, 0, At, B0); PG8_BAR; PG8_SCHED;
            PG8_LDB(B1, 1, 1); PG8_STAGE(PG8_SB(1, 0), b3, voffB);
            PG8_BAR; PG8_WAIT_L(0); PG8_MMA(0, 1, At, B1); PG8_BAR;
            PG8_LDA(At, 1, 1); PG8_STAGE(PG8_SA(1, 0), a3, voffA);
            PG8_BAR; PG8_WAIT_L(0); PG8_MMA(1, 0, At, B0); PG8_BAR; PG8_SCHED;
            PG8_STAGE(PG8_SB(1, 1), b3 + hstep, voffB);
            PG8_WAIT_V(6); PG8_BAR; PG8_MMA(1, 1, At, B1); PG8_BAR;
        }
        E(acc, cur, wr, wc, fr, fq);
        if (!has_next) break;
#pragma unroll
        for (int a = 0; a < 2; ++a)
#pragma unroll
            for (int b = 0; b < 2; ++b)
#pragma unroll
                for (int m = 0; m < 4; ++m)
#pragma unroll
                    for (int n = 0; n < 2; ++n) acc[a][b][m][n] = (f32x4){0.f, 0.f, 0.f, 0.f};
        cur = nxt; cA = nA; cB = nB; ++ui;
    }
    PG8_WAIT_V(0);
    if (wr == 0) PG8_BAR;
    PG8_BAR;
#undef PG8_SA
#undef PG8_SB
#undef PG8_STAGE
#undef PG8_LDA
#undef PG8_LDB
#undef PG8_MMA
#undef PG8_WAIT_V
#undef PG8_WAIT_L
#undef PG8_BAR
#undef PG8_SCHED
}
}

template <bool SSP> struct EpiScaleBf16 {
    bf16_t* O; int ldc; const float* rs;
    __device__ __forceinline__ void operator()(const f32x4 (&acc)[2][2][4][2], const pg8::Unit& u, int wr, int wc, int fr, int fq) const {
        const int row0 = u.pm * 256 + wr * 64 + fr, col0 = u.pn * 256 + wc * 32 + 8 * fq;
#pragma unroll
        for (int ai = 0; ai < 2; ++ai)
#pragma unroll
            for (int m = 0; m < 4; ++m) {
                const int row = row0 + ai * 128 + m * 16;
                float s;
                if (SSP) { const f32x4* q = (const f32x4*)(rs + (size_t)row * 32) + 2 * fq;
                    const f32x4 t = q[0] + q[1];
                    float ts = t[0] + t[1] + t[2] + t[3];
                    ts += __shfl_xor(ts, 16); ts += __shfl_xor(ts, 32);
                    s = rsqrtf(ts * (1.f / 2048.f) + EPS); }
                else s = rs[row];
                bf16_t* rowp = O + (size_t)row * ldc + col0;
#pragma unroll
                for (int bj = 0; bj < 2; ++bj) *(u32x4*)(rowp + bj * 128) = pack8(acc[ai][bj][m][0] * s, acc[ai][bj][m][1] * s);
            }
    }
};
struct EpiResid {
    const float* resP; const float* resS; float* Y; bf16_t* Xb; float* ssp; float* P1;
    __device__ __forceinline__ void operator()(const f32x4 (&acc)[2][2][4][2], const pg8::Unit& u, int wr, int wc, int fr, int fq) const {
        const int row0 = u.pm * 256 + wr * 64 + fr, col0 = u.pn * 256 + wc * 32 + 8 * fq;
        if (u.ks != 0) {
#pragma unroll
            for (int ai = 0; ai < 2; ++ai)
#pragma unroll
                for (int m = 0; m < 4; ++m) {
                    float* yp = P1 + (size_t)(row0 + ai * 128 + m * 16) * DM + col0;
#pragma unroll
                    for (int bj = 0; bj < 2; ++bj) { *(f32x4*)(yp + bj * 128) = acc[ai][bj][m][0]; *(f32x4*)(yp + bj * 128 + 4) = acc[ai][bj][m][1]; }
                }
            return;
        }
#pragma unroll
        for (int ai = 0; ai < 2; ++ai) {
            f32x4 r[4][2][2];
#pragma unroll
            for (int m = 0; m < 4; ++m) {
                const int row = row0 + ai * 128 + m * 16;
                const float* res = (row < NPT ? resP + (size_t)row * DM : resS + (size_t)(row - NPT) * DM) + col0;
#pragma unroll
                for (int bj = 0; bj < 2; ++bj) { r[m][bj][0] = *(const f32x4*)(res + bj * 128); r[m][bj][1] = *(const f32x4*)(res + bj * 128 + 4); }
            }
            __builtin_amdgcn_sched_barrier(0);
#pragma unroll
            for (int m = 0; m < 4; ++m) {
                const int row = row0 + ai * 128 + m * 16;
                float* yp = Y + (size_t)row * DM + col0;
                float ss = 0.f;
#pragma unroll
                for (int bj = 0; bj < 2; ++bj) {
                    const f32x4 v0 = acc[ai][bj][m][0] + r[m][bj][0], v1 = acc[ai][bj][m][1] + r[m][bj][1];
                    *(f32x4*)(yp + bj * 128) = v0; *(f32x4*)(yp + bj * 128 + 4) = v1;
                    if (Xb) *(u32x4*)(Xb + (size_t)row * DM + col0 + bj * 128) = pack8(v0, v1);
                    ss += v0[0] * v0[0] + v0[1] * v0[1] + v0[2] * v0[2] + v0[3] * v0[3] + v1[0] * v1[0] + v1[1] * v1[1] + v1[2] * v1[2] + v1[3] * v1[3];
                }
                if (ssp) {
                    ss += __shfl_xor(ss, 16); ss += __shfl_xor(ss, 32);
                    if (fq == 0) ssp[(size_t)row * 32 + u.pn * 4 + wc] = ss;
                }
            }
        }
    }
};

__device__ __forceinline__ void conv_tile(const float* __restrict__ W, int N, int src, const float* __restrict__ gk, bf16_t* __restrict__ dst, int k0) {
    float v[64];
#pragma unroll
    for (int j = 0; j < 64; ++j) v[j] = __builtin_nontemporal_load(W + (size_t)(k0 + j) * N + src);
    if (gk) {
#pragma unroll
        for (int j = 0; j < 64; ++j) v[j] *= gk[k0 + j];
    }
#pragma unroll
    for (int kb = 0; kb < 64; kb += 8) {
        u32x4 a;
        a.x = pk_bf16(v[kb], v[kb + 1]); a.y = pk_bf16(v[kb + 2], v[kb + 3]); a.z = pk_bf16(v[kb + 4], v[kb + 5]); a.w = pk_bf16(v[kb + 6], v[kb + 7]);
        *(u32x4*)(dst + kb) = a;
    }
}

__device__ __forceinline__ void phase0(const Params& p, LAS unsigned char* lds) {
    const int tid = opaque_tid(), wave = tid >> 6, lane = tid & 63, fr = lane & 15, fq = lane >> 4;
    const int G = gridDim.x, GW = G * 8, gw = wave * G + blockIdx.x;
    const float* w_in = p.in[9]; const float* g1 = p.in[8];
    unsigned char* ws = p.ws;
    constexpr int WGS = 4112;
    {
        const int n = tid & 31, kb = tid >> 5;
        const int col = n < 16 ? 4096 + n : 7184 + (n - 16);
#pragma unroll 1
        for (int k0 = 0; k0 < 2048; k0 += 512) {
            float v[32], gg[32];
#pragma unroll
            for (int i = 0; i < 32; ++i) { const int k = k0 + 16 * i + kb; v[i] = n < 24 ? w_in[(size_t)k * PROJ_COLS + col] : 0.f; gg[i] = g1[k]; }
#pragma unroll
            for (int i = 0; i < 32; ++i) { const int k = k0 + 16 * i + kb; *(LAS bf16_t*)(lds + n * WGS + k * 2) = f2bf(v[i] * gg[i]); }
        }
    }
    if (blockIdx.x == 0 && tid == 0) { unsigned* c_ = (unsigned*)(ws + W_CTR); c_[0] = 0u; c_[32] = 0u; c_[48] = 0u; }
    __syncthreads();
    bf16_t* xb = (bf16_t*)(ws + W_XB); float* rstd1 = (float*)(ws + W_RSTD1); float* gates = (float*)(ws + W_GATES);
    for (int t = gw; t < 576; t += GW) {
        const int R0 = t * 16, row = R0 + fr;
        const float* xr = xrow(p, row);
        f32x4 acc0 = {0.f, 0.f, 0.f, 0.f}, acc1 = {0.f, 0.f, 0.f, 0.f}; float ss = 0.f;
#pragma unroll 2
        for (int kb = 0; kb < 64; kb += 8) {
            f32x4 xa[8], xb4[8];
#pragma unroll
            for (int i = 0; i < 8; ++i) { xa[i] = __builtin_nontemporal_load((const f32x4*)(xr + (kb + i) * 32 + fq * 8)); xb4[i] = __builtin_nontemporal_load((const f32x4*)(xr + (kb + i) * 32 + fq * 8 + 4)); }
#pragma unroll
            for (int i = 0; i < 8; ++i) {
                const int kk = kb + i; const f32x4 a = xa[i], b = xb4[i];
                ss += a[0] * a[0] + a[1] * a[1] + a[2] * a[2] + a[3] * a[3] + b[0] * b[0] + b[1] * b[1] + b[2] * b[2] + b[3] * b[3];
                const u32x4 A = pack8(a, b);
                *(u32x4*)(xb + (size_t)row * DM + kk * 32 + fq * 8) = A;
                const bf16x8 B0 = *(const LAS bf16x8*)(lds + fr * WGS + (kk * 32 + fq * 8) * 2);
                const bf16x8 B1 = *(const LAS bf16x8*)(lds + (16 + fr) * WGS + (kk * 32 + fq * 8) * 2);
                acc0 = __builtin_amdgcn_mfma_f32_16x16x32_bf16(as_bf16x8(A), B0, acc0, 0, 0, 0);
                acc1 = __builtin_amdgcn_mfma_f32_16x16x32_bf16(as_bf16x8(A), B1, acc1, 0, 0, 0);
            }
        }
        ss += __shfl_xor(ss, 16); ss += __shfl_xor(ss, 32);
        const float rs = rsqrtf(ss * (1.f / 2048.f) + EPS);
        if (fq == 0) rstd1[row] = rs;
#pragma unroll
        for (int j = 0; j < 4; ++j) {
            const int m = fq * 4 + j; const float rm = __shfl(rs, m);
            gates[(size_t)(R0 + m) * 32 + fr] = acc0[j] * rm;
            if (fr < 8) gates[(size_t)(R0 + m) * 32 + 16 + fr] = acc1[j] * rm;
        }
    }
    if (gw >= 576 || GW <= 576) {
        const int cw = GW > 576 ? gw - 576 : gw, CW = GW > 576 ? GW - 576 : GW;
        for (int t = cw; t < 4608; t += CW) {
            if (t < 3584) { const int kt = t & 31, ntile = t >> 5, n = ntile * 64 + lane, src = n < 4096 ? n : n + 16;
                conv_tile(w_in, PROJ_COLS, src, g1, (bf16_t*)(ws + W_WIN) + (size_t)n * 2048 + kt * 64, kt * 64); }
            else { const int tt = t - 3584, kt = tt & 31, n = (tt >> 5) * 64 + lane;
                conv_tile(p.in[17], 2048, n, nullptr, (bf16_t*)(ws + W_WOUT) + (size_t)n * 2048 + kt * 64, kt * 64); }
        }
    }
}
__device__ __forceinline__ void convert_task(const Params& p, int t, int lane) {
    unsigned char* ws = p.ws;
    if (t < 5632) { const int kt = t & 31, n = (t >> 5) * 64 + lane;
        conv_tile(p.in[19], FF2, n, p.in[18], (bf16_t*)(ws + W_WUP) + (size_t)n * 2048 + kt * 64, kt * 64); }
    else { const int tt = t - 5632, kt = tt % 88, n = (tt / 88) * 64 + lane;
        conv_tile(p.in[22], 2048, n, nullptr, (bf16_t*)(ws + W_WDOWN) + (size_t)n * FF + kt * 64, kt * 64); }
}
__device__ __forceinline__ void convert_late(const Params& p) {
    const int lane = opaque_tid() & 63;
    unsigned* ctr = (unsigned*)(p.ws + W_CTR);
    for (;;) {
        unsigned tu = 0;
        if (lane == 0) tu = atomicAdd(ctr, 1u);
        const int t = __builtin_amdgcn_readfirstlane((int)tu);
        if (t >= 8448) break;
        convert_task(p, t, lane);
    }
}
__device__ __forceinline__ void convert_one(const Params& p, int lane) {
    unsigned* ctr = (unsigned*)(p.ws + W_CTR);
    unsigned tu = 0;
    if (lane == 0) tu = atomicAdd(ctr, 1u);
    const int t = __builtin_amdgcn_readfirstlane((int)tu);
    if (t < 8448) convert_task(p, t, lane);
}
__device__ __forceinline__ void signal_done(unsigned* c) {
    asm volatile("s_waitcnt vmcnt(0)" ::: "memory");
    __syncthreads();
    if (threadIdx.x == 0) {
        __builtin_amdgcn_fence(__ATOMIC_RELEASE, "agent");
        asm volatile("s_waitcnt vmcnt(0)" ::: "memory");
        (void)__hip_atomic_fetch_add(c, 1u, __ATOMIC_RELAXED, __HIP_MEMORY_SCOPE_AGENT);
    }
}
__device__ __forceinline__ void wait_count(unsigned* c, unsigned need) {
    if (threadIdx.x == 0) {
        unsigned sp = 0u;
        while (__hip_atomic_load(c, __ATOMIC_RELAXED, __HIP_MEMORY_SCOPE_AGENT) < need) { __builtin_amdgcn_s_sleep(2); if (++sp > (1u << 20)) break; }
        __builtin_amdgcn_fence(__ATOMIC_ACQUIRE, "agent");
        asm volatile("s_waitcnt vmcnt(0)" ::: "memory");
    }
    __syncthreads();
}

__device__ __forceinline__ void phase2(const Params& p, LAS unsigned char* lds) {
    const int tid = opaque_tid(), wave = tid >> 6, lane = tid & 63, fr = lane & 15, fq = lane >> 4;
    unsigned char* ws = p.ws;
    const bf16_t* proj = (const bf16_t*)(ws + W_PROJ); const float* gates = (const float*)(ws + W_GATES);
    const float* convw = p.in[10];
    constexpr int L_Q = 0, L_K = 33792, L_V = 67584, L_QN = 101376, L_KN = 118784, L_SM = 136192, L_A = 0;
    LAS float* s_beta = (LAS float*)(lds + L_SM); LAS float* s_G = s_beta + 64; LAS float* s_eG = s_beta + 128; LAS float* s_ekd = s_beta + 192;
    for (int item = blockIdx.x; item < 1024; item += gridDim.x) {
        const int n = item & 31, h = (item >> 5) & 7, b = item >> 8;
        const int tok0 = b * SEQL + n * 64;
        unsigned char* ib = ws + W_ITEMS + (size_t)item * ITEM_STRIDE;
        if (tid < 384) {
            const int cgp = tid % 48, rr = tid / 48, sec = cgp >> 4, d0 = (cgp & 15) * 8, ch = sec * 1024 + h * 128 + d0;
            float w[4][8];
#pragma unroll
            for (int j = 0; j < 4; ++j) { const f32x4 a = *(const f32x4*)(convw + j * 3072 + ch), c = *(const f32x4*)(convw + j * 3072 + ch + 4);
                w[j][0] = a[0]; w[j][1] = a[1]; w[j][2] = a[2]; w[j][3] = a[3]; w[j][4] = c[0]; w[j][5] = c[1]; w[j][6] = c[2]; w[j][7] = c[3]; }
            u32x4 xw[11];
#pragma unroll
            for (int i = 0; i < 11; ++i) { const int t = n * 64 + rr * 8 - 3 + i;
                xw[i] = t >= 0 ? *(const u32x4*)(proj + (size_t)(tok0 + rr * 8 - 3 + i) * PCOL + ch) : (u32x4){0u, 0u, 0u, 0u}; }
            LAS float* dst = (LAS float*)(lds + (sec == 0 ? L_Q : sec == 1 ? L_K : L_V));
#pragma unroll
            for (int i = 0; i < 8; ++i) {
                float o[8];
#pragma unroll
                for (int e = 0; e < 8; ++e) o[e] = 0.f;
#pragma unroll
                for (int j = 0; j < 4; ++j) { const u32x4 x = xw[i + j];
                    o[0] += w[j][0] * bf_lo(x.x); o[1] += w[j][1] * bf_hi(x.x); o[2] += w[j][2] * bf_lo(x.y); o[3] += w[j][3] * bf_hi(x.y);
                    o[4] += w[j][4] * bf_lo(x.z); o[5] += w[j][5] * bf_hi(x.z); o[6] += w[j][6] * bf_lo(x.w); o[7] += w[j][7] * bf_hi(x.w); }
                LAS float* d = dst + (rr * 8 + i) * 132 + d0;
                *(LAS f32x4*)d = (f32x4){siluf(o[0]), siluf(o[1]), siluf(o[2]), siluf(o[3])};
                *(LAS f32x4*)(d + 4) = (f32x4){siluf(o[4]), siluf(o[5]), siluf(o[6]), siluf(o[7])};
            }
        }
        if (wave == 7) {
            const int row = tok0 + lane;
            const float be = sigm(gates[(size_t)row * 32 + h]);
            const float g = -__expf(p.in[11][h]) * softplusf(gates[(size_t)row * 32 + 8 + h] + p.in[12][h]);
            float Gc = g;
#pragma unroll
            for (int d = 1; d < 64; d <<= 1) { const float t = __shfl_up(Gc, d); if (lane >= d) Gc += t; }
            const float Gl = __shfl(Gc, 63);
            s_beta[lane] = be; s_G[lane] = Gc; s_eG[lane] = __expf(Gc); s_ekd[lane] = __expf(Gl - Gc);
            if (lane == 0) *(float*)(ib + IT_GL) = __expf(Gl);
        }
        __syncthreads();
        {
            const int row = tid >> 2, part = tid & 3, isk = row >> 6, r = row & 63;
            const LAS float* src = (const LAS float*)(lds + (isk ? L_K : L_Q)) + r * 132 + part * 32;
            f32x4 v[8]; float ss = 0.f;
#pragma unroll
            for (int i = 0; i < 8; ++i) { v[i] = *(const LAS f32x4*)(src + i * 4); ss += v[i][0] * v[i][0] + v[i][1] * v[i][1] + v[i][2] * v[i][2] + v[i][3] * v[i][3]; }
            ss += __shfl_xor(ss, 1); ss += __shfl_xor(ss, 2);
            const float rn = rsqrtf(ss + EPS) * (isk ? 1.f : 0.08838834764831845f);
            LAS unsigned char* dst = lds + (isk ? L_KN : L_QN) + r * 272 + part * 64;
#pragma unroll
            for (int i = 0; i < 4; ++i) *(LAS u32x4*)(dst + i * 16) = pack8(v[2 * i] * rn, v[2 * i + 1] * rn);
        }
        __syncthreads();
        {
#pragma unroll
            for (int q = 0; q < 4; ++q) {
                const int tt = wave * 4 + q, which = tt >> 4, it = (tt & 15) >> 2, jt = tt & 3;
                f32x4 acc = {0.f, 0.f, 0.f, 0.f};
                const LAS unsigned char* ap = lds + (which ? L_QN : L_KN) + (16 * it + fr) * 272 + fq * 16;
                const LAS unsigned char* bp = lds + L_KN + (16 * jt + fr) * 272 + fq * 16;
#pragma unroll
                for (int kk = 0; kk < 4; ++kk) acc = __builtin_amdgcn_mfma_f32_16x16x32_bf16(*(const LAS bf16x8*)(ap + kk * 64), *(const LAS bf16x8*)(bp + kk * 64), acc, 0, 0, 0);
                const int j = 16 * jt + fr; const float Gj = s_G[j];
#pragma unroll
                for (int e = 0; e < 4; ++e) {
                    const int i = 16 * it + 4 * fq + e;
                    const float dec = __expf(fminf(s_G[i] - Gj, 0.f));
                    if (which == 0) ((LAS float*)(lds + L_A))[j * 68 + i] = (i > j) ? acc[e] * s_beta[i] * dec : 0.f;
                    else *(bf16_t*)(ib + IT_QK + i * 144 + j * 2) = f2bf((i >= j) ? acc[e] * dec : 0.f);
                }
            }
        }
        __syncthreads();
        if (tid < 256) {
            const LAS float* At = (const LAS float*)(lds + L_A);
            const bool isu = tid < 128; const int col = isu ? tid : tid - 128;
            LAS float* X = (LAS float*)(lds + (isu ? L_V : L_K)) + col;
#pragma unroll 1
            for (int blk = 0; blk < 4; ++blk) {
                float acc[16];
#pragma unroll
                for (int ii = 0; ii < 16; ++ii) { const int i = 16 * blk + ii;
                    acc[ii] = isu ? X[i * 132] * s_beta[i] : bf2f(*(const LAS bf16_t*)(lds + L_KN + i * 272 + col * 2)) * s_beta[i] * s_eG[i]; }
#pragma unroll 4
                for (int j = 0; j < 16 * blk; ++j) {
                    const float xj = X[j * 132];
                    const LAS float* ar = At + j * 68 + 16 * blk;
                    const f32x4 a0 = *(const LAS f32x4*)ar, a1 = *(const LAS f32x4*)(ar + 4), a2 = *(const LAS f32x4*)(ar + 8), a3 = *(const LAS f32x4*)(ar + 12);
#pragma unroll
                    for (int e = 0; e < 4; ++e) { acc[e] -= a0[e] * xj; acc[4 + e] -= a1[e] * xj; acc[8 + e] -= a2[e] * xj; acc[12 + e] -= a3[e] * xj; }
                }
#pragma unroll
                for (int jj = 0; jj < 15; ++jj) {
                    const float xj = acc[jj];
                    const LAS float* ar = At + (16 * blk + jj) * 68 + 16 * blk;
                    const f32x4 a0 = *(const LAS f32x4*)ar, a1 = *(const LAS f32x4*)(ar + 4), a2 = *(const LAS f32x4*)(ar + 8), a3 = *(const LAS f32x4*)(ar + 12);
                    const float av[16] = {a0[0], a0[1], a0[2], a0[3], a1[0], a1[1], a1[2], a1[3], a2[0], a2[1], a2[2], a2[3], a3[0], a3[1], a3[2], a3[3]};
#pragma unroll
                    for (int ii = jj + 1; ii < 16; ++ii) acc[ii] -= av[ii] * xj;
                }
#pragma unroll
                for (int ii = 0; ii < 16; ++ii) X[(16 * blk + ii) * 132] = acc[ii];
            }
            if (isu) {
#pragma unroll 1
                for (int i = 0; i < 8; ++i) { u32x4 w; w.x = pk_bf16(X[(8 * i) * 132], X[(8 * i + 1) * 132]); w.y = pk_bf16(X[(8 * i + 2) * 132], X[(8 * i + 3) * 132]);
                    w.z = pk_bf16(X[(8 * i + 4) * 132], X[(8 * i + 5) * 132]); w.w = pk_bf16(X[(8 * i + 6) * 132], X[(8 * i + 7) * 132]);
                    *(u32x4*)(ib + IT_UT + col * 144 + i * 16) = w; }
            } else {
#pragma unroll 4
                for (int i = 0; i < 64; ++i) *(bf16_t*)(ib + IT_W + i * 272 + col * 2) = f2bf(X[i * 132]);
            }
        } else {
            const int t2 = tid - 256;
            { const int i = t2 >> 2, part = t2 & 3; const float sc = s_eG[i];
#pragma unroll
              for (int q = 0; q < 4; ++q) { const u32x4 v = *(const LAS u32x4*)(lds + L_QN + i * 272 + part * 64 + q * 16); u32x4 w;
                  w.x = pk_bf16(bf_lo(v.x) * sc, bf_hi(v.x) * sc); w.y = pk_bf16(bf_lo(v.y) * sc, bf_hi(v.y) * sc); w.z = pk_bf16(bf_lo(v.z) * sc, bf_hi(v.z) * sc); w.w = pk_bf16(bf_lo(v.w) * sc, bf_hi(v.w) * sc);
                  *(u32x4*)(ib + IT_QE + i * 272 + part * 64 + q * 16) = w; } }
            { const int k = t2 & 127, cg2 = t2 >> 7;
#pragma unroll
              for (int q = 0; q < 4; ++q) { float v[8];
#pragma unroll
                  for (int e = 0; e < 8; ++e) { const int c = cg2 * 32 + q * 8 + e; v[e] = bf2f(*(const LAS bf16_t*)(lds + L_KN + c * 272 + k * 2)) * s_ekd[c]; }
                  u32x4 w; w.x = pk_bf16(v[0], v[1]); w.y = pk_bf16(v[2], v[3]); w.z = pk_bf16(v[4], v[5]); w.w = pk_bf16(v[6], v[7]);
                  *(u32x4*)(ib + IT_KDT + k * 144 + cg2 * 64 + q * 16) = w; } }
            convert_one(p, lane);
        }
        __syncthreads();
    }
    {
        float* out = p.out;
        const int gt = blockIdx.x * 512 + tid, GT = gridDim.x * 512;
        for (int i = gt; i < 128 * 3 * 3072; i += GT) { const int c = i % 3072, j = (i / 3072) % 3, s = i / 9216;
            out[O_S_DNCONV + i] = bf2f(proj[(size_t)(NPT + 8 * s + 5 + j) * PCOL + c]); }
        for (int i = gt; i < 4 * 3 * 3072; i += GT) { const int c = i % 3072, j = (i / 3072) % 3, b = i / 9216;
            out[O_P_DNCONV + i] = bf2f(proj[(size_t)(b * SEQL + 2045 + j) * PCOL + c]); }
    }
}

__device__ __forceinline__ bf16x8 frag2(const LAS unsigned char* p) {
    const u32x2 a = *(const LAS u32x2*)p, b = *(const LAS u32x2*)(p + 32); u32x4 w; w.x = a.x; w.y = a.y; w.z = b.x; w.w = b.y; return as_bf16x8(w);
}
#define MFMA16(A, B, C) __builtin_amdgcn_mfma_f32_16x16x32_bf16((A), (B), (C), 0, 0, 0)

__device__ __forceinline__ void scan_dn(const Params& p, LAS unsigned char* lds, int bh) {
    const int tid = opaque_tid(), wave = tid >> 6, lane = tid & 63, fr = lane & 15, fq = lane >> 4;
    const int b = bh >> 3, h = bh & 7;
    unsigned char* ws = p.ws;
    const bf16_t* proj = (const bf16_t*)(ws + W_PROJ); bf16_t* mix = (bf16_t*)(ws + W_MIX);
    const unsigned char* items = ws + W_ITEMS + (size_t)bh * 32 * ITEM_STRIDE;
    constexpr int L_O = 81920;
    f32x4 S[8];
#pragma unroll
    for (int i = 0; i < 8; ++i) S[i] = (f32x4){0.f, 0.f, 0.f, 0.f};
    u32x4 pf[10];
#pragma unroll
    for (int i = 0; i < 10; ++i) { const int idx = tid + 512 * i; if (idx < ITEM_COPY16) pf[i] = __builtin_nontemporal_load((const u32x4*)(items + (size_t)idx * 16)); }
    const bf16_t* zbase = proj + (size_t)(b * SEQL + (tid >> 3)) * PCOL + PC_DNZ + h * 128 + (tid & 7) * 16;
    u32x4 zc0 = *(const u32x4*)zbase, zc1 = *(const u32x4*)(zbase + 8), zn0 = zc0, zn1 = zc1;
    f32x4 gpv[4];
#pragma unroll
    for (int i = 0; i < 4; ++i) gpv[i] = *(const f32x4*)(p.in[13] + (tid & 7) * 16 + 4 * i);
    for (int n = 0; n < 32; ++n) {
#pragma unroll
        for (int i = 0; i < 10; ++i) { const int idx = tid + 512 * i; if (idx < ITEM_COPY16) *(LAS u32x4*)(lds + idx * 16) = pf[i]; }
        __syncthreads();
        if (n + 1 < 32) {
            const unsigned char* nx = items + (size_t)(n + 1) * ITEM_STRIDE;
#pragma unroll
            for (int i = 0; i < 10; ++i) { const int idx = tid + 512 * i; if (idx < ITEM_COPY16) pf[i] = __builtin_nontemporal_load((const u32x4*)(nx + (size_t)idx * 16)); }
            zn0 = *(const u32x4*)(zbase + (size_t)(n + 1) * 64 * PCOL); zn1 = *(const u32x4*)(zbase + (size_t)(n + 1) * 64 * PCOL + 8);
        }
        const float gl = *(const LAS float*)(lds + IT_GL);
        bf16x8 Bs[4];
#pragma unroll
        for (int kk = 0; kk < 4; ++kk) Bs[kk] = as_bf16x8(pack8(S[2 * kk], S[2 * kk + 1]));
        f32x4 T1[4], T2[4];
#pragma unroll
        for (int mt = 0; mt < 4; ++mt) {
            T1[mt] = (f32x4){0.f, 0.f, 0.f, 0.f}; T2[mt] = (f32x4){0.f, 0.f, 0.f, 0.f};
#pragma unroll
            for (int kk = 0; kk < 4; ++kk) {
                T1[mt] = MFMA16(frag2(lds + IT_W + (16 * mt + fr) * 272 + kk * 64 + fq * 8), Bs[kk], T1[mt]);
                T2[mt] = MFMA16(frag2(lds + IT_QE + (16 * mt + fr) * 272 + kk * 64 + fq * 8), Bs[kk], T2[mt]);
            }
        }
#pragma unroll
        for (int mt = 0; mt < 4; ++mt) {
            const u32x2 uu = *(const LAS u32x2*)(lds + IT_UT + (16 * wave + fr) * 144 + (16 * mt + 4 * fq) * 2);
            T1[mt] = (f32x4){bf_lo(uu.x) - T1[mt][0], bf_hi(uu.x) - T1[mt][1], bf_lo(uu.y) - T1[mt][2], bf_hi(uu.y) - T1[mt][3]};
        }
        bf16x8 Bv[2];
#pragma unroll
        for (int kc = 0; kc < 2; ++kc) Bv[kc] = as_bf16x8(pack8(T1[2 * kc], T1[2 * kc + 1]));
#pragma unroll
        for (int mt = 0; mt < 4; ++mt)
#pragma unroll
            for (int kc = 0; kc < 2; ++kc) T2[mt] = MFMA16(frag2(lds + IT_QK + (16 * mt + fr) * 144 + kc * 64 + fq * 8), Bv[kc], T2[mt]);
#pragma unroll
        for (int mk = 0; mk < 8; ++mk) {
            S[mk] *= gl;
#pragma unroll
            for (int kc = 0; kc < 2; ++kc) S[mk] = MFMA16(frag2(lds + IT_KDT + (16 * mk + fr) * 144 + kc * 64 + fq * 8), Bv[kc], S[mk]);
        }
#pragma unroll
        for (int mt = 0; mt < 4; ++mt)
#pragma unroll
            for (int e = 0; e < 4; ++e) ((LAS float*)(lds + L_O))[(16 * mt + 4 * fq + e) * 132 + 16 * wave + fr] = T2[mt][e];
        __syncthreads();
        {
            const int c = tid >> 3, part = tid & 7, row = b * SEQL + n * 64 + c;
            const LAS float* op = (const LAS float*)(lds + L_O) + c * 132 + part * 16;
            f32x4 v[4]; float ss = 0.f;
#pragma unroll
            for (int i = 0; i < 4; ++i) { v[i] = *(const LAS f32x4*)(op + 4 * i); ss += v[i][0] * v[i][0] + v[i][1] * v[i][1] + v[i][2] * v[i][2] + v[i][3] * v[i][3]; }
            ss += __shfl_xor(ss, 1); ss += __shfl_xor(ss, 2); ss += __shfl_xor(ss, 4);
            const float rn = rsqrtf(ss * (1.f / 128.f) + EPS);
            const u32x4 z0 = zc0, z1 = zc1;
            const float gp[16] = {gpv[0][0], gpv[0][1], gpv[0][2], gpv[0][3], gpv[1][0], gpv[1][1], gpv[1][2], gpv[1][3], gpv[2][0], gpv[2][1], gpv[2][2], gpv[2][3], gpv[3][0], gpv[3][1], gpv[3][2], gpv[3][3]};
            float zz[16] = {bf_lo(z0.x), bf_hi(z0.x), bf_lo(z0.y), bf_hi(z0.y), bf_lo(z0.z), bf_hi(z0.z), bf_lo(z0.w), bf_hi(z0.w),
                            bf_lo(z1.x), bf_hi(z1.x), bf_lo(z1.y), bf_hi(z1.y), bf_lo(z1.z), bf_hi(z1.z), bf_lo(z1.w), bf_hi(z1.w)};
            float o[16];
#pragma unroll
            for (int i = 0; i < 16; ++i) o[i] = v[i >> 2][i & 3] * rn * gp[i] * siluf(zz[i]);
            u32x4 w0, w1;
            w0.x = pk_bf16(o[0], o[1]); w0.y = pk_bf16(o[2], o[3]); w0.z = pk_bf16(o[4], o[5]); w0.w = pk_bf16(o[6], o[7]);
            w1.x = pk_bf16(o[8], o[9]); w1.y = pk_bf16(o[10], o[11]); w1.z = pk_bf16(o[12], o[13]); w1.w = pk_bf16(o[14], o[15]);
            bf16_t* mp = mix + (size_t)row * DM + h * 128 + part * 16;
            *(u32x4*)mp = w0; *(u32x4*)(mp + 8) = w1;
            zc0 = zn0; zc1 = zn1;
        }
    }
    int l2 = tid; asm volatile("" : "+v"(l2));
    float* so = p.out + O_P_DNS + (size_t)bh * 128 * 128 + (size_t)(4 * ((l2 & 63) >> 4)) * 128 + 16 * (l2 >> 6) + (l2 & 15);
#pragma unroll
    for (int mk = 0; mk < 8; ++mk)
#pragma unroll
        for (int e = 0; e < 4; ++e) so[(16 * mk + e) * 128] = S[mk][e];
}

struct MlGate { float bc, av, Mi, M63, b63; };
__device__ __forceinline__ MlGate ml_gates(const float* gates, int tok0, int lane, int h, float fb, float ib, float m_prev) {
    const float fg = logsigm(gates[(size_t)(tok0 + lane) * 32 + 20 + h] + fb), ig = gates[(size_t)(tok0 + lane) * 32 + 16 + h] + ib;
    float bc = fg;
#pragma unroll
    for (int d = 1; d < 64; d <<= 1) { const float t = __shfl_up(bc, d); if (lane >= d) bc += t; }
    const float av = ig - bc;
    float pm = av;
#pragma unroll
    for (int d = 1; d < 64; d <<= 1) { const float t = __shfl_up(pm, d); if (lane >= d) pm = fmaxf(pm, t); }
    MlGate g; g.bc = bc; g.av = av; g.Mi = fmaxf(m_prev, pm); g.M63 = __shfl(g.Mi, 63); g.b63 = __shfl(bc, 63);
    return g;
}

__device__ __forceinline__ void ml_passA(const Params& p, LAS unsigned char* lds, int item) {
    const int tid = opaque_tid(), wave = tid >> 6, lane = tid & 63, fr = lane & 15, fq = lane >> 4;
    const int n = item & 31, bh = item >> 5, h = bh & 3, b = bh >> 2, tok0 = b * SEQL + n * 64;
    unsigned char* ws = p.ws;
    const bf16_t* proj = (const bf16_t*)(ws + W_PROJ); const float* gates = (const float*)(ws + W_GATES);
    constexpr int L_KT = 0, L_VT = 18432, L_RED = 55296;
    LAS float* red = (LAS float*)(lds + L_RED);
    const float ib = p.in[14][h], fb = p.in[15][h];
    float m_prev;
    {
        float fl[4], il[4], lsum = 0.f;
#pragma unroll
        for (int e = 0; e < 4; ++e) { const int sidx = tid * 4 + e; float f = 0.f, iv = -3.0e38f;
            if (sidx < n * 64) { const size_t row = (size_t)(b * SEQL + sidx); f = logsigm(gates[row * 32 + 20 + h] + fb); iv = gates[row * 32 + 16 + h] + ib; }
            lsum += f; fl[e] = lsum; il[e] = iv; }
        float incl = lsum;
#pragma unroll
        for (int d = 1; d < 64; d <<= 1) { const float t = __shfl_up(incl, d); if (lane >= d) incl += t; }
        if (lane == 63) red[wave] = incl;
        __syncthreads();
        float woff = 0.f, ftot = 0.f;
#pragma unroll
        for (int w = 0; w < 8; ++w) { const float r = red[w]; ftot += r; if (w < wave) woff += r; }
        const float excl = woff + incl - lsum;
        float mx = -3.0e38f;
#pragma unroll
        for (int e = 0; e < 4; ++e) mx = fmaxf(mx, il[e] - (excl + fl[e]));
#pragma unroll
        for (int d = 32; d >= 1; d >>= 1) mx = fmaxf(mx, __shfl_xor(mx, d));
        if (lane == 0) red[8 + wave] = mx;
        __syncthreads();
        float gm = 0.f;
#pragma unroll
        for (int w = 0; w < 8; ++w) gm = fmaxf(gm, red[8 + w]);
        m_prev = ftot + gm;
    }
    const MlGate g = ml_gates(gates, tok0, lane, h, fb, ib, m_prev);
    const float wend = __expf(g.av - g.M63), cs = __expf(m_prev - g.M63);
    const int lr = tid >> 3, lp = tid & 7;
    {
        const bf16_t* rp = proj + (size_t)(tok0 + lr) * PCOL;
        const u32x4 pk0 = *(const u32x4*)(rp + PC_MLK + h * 128 + lp * 16), pk1 = *(const u32x4*)(rp + PC_MLK + h * 128 + lp * 16 + 8);
        u32x4 pv[4];
#pragma unroll
        for (int i = 0; i < 4; ++i) pv[i] = *(const u32x4*)(rp + PC_MLV + h * 256 + lp * 32 + i * 8);
        const float we = __shfl(wend, lr & 63);
        const unsigned kw[8] = {pk0.x, pk0.y, pk0.z, pk0.w, pk1.x, pk1.y, pk1.z, pk1.w};
#pragma unroll
        for (int e = 0; e < 8; ++e) {
            *(LAS bf16_t*)(lds + L_KT + (lp * 16 + 2 * e) * 144 + lr * 2) = f2bf(bf_lo(kw[e]) * we);
            *(LAS bf16_t*)(lds + L_KT + (lp * 16 + 2 * e + 1) * 144 + lr * 2) = f2bf(bf_hi(kw[e]) * we);
        }
#pragma unroll
        for (int i = 0; i < 4; ++i) { const unsigned vw[4] = {pv[i].x, pv[i].y, pv[i].z, pv[i].w};
#pragma unroll
            for (int e = 0; e < 4; ++e) {
                *(LAS bf16_t*)(lds + L_VT + (lp * 32 + i * 8 + 2 * e) * 144 + lr * 2) = (bf16_t)(vw[e] & 0xffffu);
                *(LAS bf16_t*)(lds + L_VT + (lp * 32 + i * 8 + 2 * e + 1) * 144 + lr * 2) = (bf16_t)(vw[e] >> 16);
            } }
    }
    __syncthreads();
    {
        bf16x8 Bv[2][2];
#pragma unroll
        for (int kc = 0; kc < 2; ++kc)
#pragma unroll
            for (int nt = 0; nt < 2; ++nt) Bv[kc][nt] = *(const LAS bf16x8*)(lds + L_VT + (32 * wave + 16 * nt + fr) * 144 + kc * 64 + fq * 16);
        unsigned char* kvb = (unsigned char*)p.out + (size_t)item * 65536;
#pragma unroll
        for (int mk = 0; mk < 8; ++mk) {
            f32x4 c0 = {0.f, 0.f, 0.f, 0.f}, c1 = {0.f, 0.f, 0.f, 0.f};
#pragma unroll
            for (int kc = 0; kc < 2; ++kc) { const bf16x8 a = *(const LAS bf16x8*)(lds + L_KT + (16 * mk + fr) * 144 + kc * 64 + fq * 16);
                c0 = MFMA16(a, Bv[kc][0], c0); c1 = MFMA16(a, Bv[kc][1], c1); }
            u32x2 w0, w1; w0.x = pk_bf16(c0[0], c0[1]); w0.y = pk_bf16(c0[2], c0[3]); w1.x = pk_bf16(c1[0], c1[1]); w1.y = pk_bf16(c1[2], c1[3]);
            *(u32x2*)(kvb + ((32 * wave + fr) * 128 + 16 * mk + 4 * fq) * 2) = w0;
            *(u32x2*)(kvb + ((32 * wave + 16 + fr) * 128 + 16 * mk + 4 * fq) * 2) = w1;
        }
        const int kd = tid >> 2, p4 = tid & 3;
        const u32x4 k0 = *(const LAS u32x4*)(lds + L_KT + kd * 144 + p4 * 32), k1 = *(const LAS u32x4*)(lds + L_KT + kd * 144 + p4 * 32 + 16);
        float ks = bf_lo(k0.x) + bf_hi(k0.x) + bf_lo(k0.y) + bf_hi(k0.y) + bf_lo(k0.z) + bf_hi(k0.z) + bf_lo(k0.w) + bf_hi(k0.w)
                 + bf_lo(k1.x) + bf_hi(k1.x) + bf_lo(k1.y) + bf_hi(k1.y) + bf_lo(k1.z) + bf_hi(k1.z) + bf_lo(k1.w) + bf_hi(k1.w);
        ks += __shfl_xor(ks, 1); ks += __shfl_xor(ks, 2);
        if (p4 == 0) ((float*)(ws + W_MLN))[(size_t)item * 128 + kd] = ks;
        if (tid == 0) { float* sc = (float*)(ws + W_MLSC) + (size_t)item * 4; sc[0] = cs; sc[1] = m_prev; sc[2] = g.b63 + g.M63; sc[3] = 0.f; }
    }
    __syncthreads();
}

__device__ __forceinline__ void ml_passB(const Params& p, int wk, int NW) {
    const int tid = opaque_tid();
    unsigned char* ws = p.ws;
    const float* sc = (const float*)(ws + W_MLSC);
    for (int task = wk * 512 + tid; task < 65536; task += NW * 512) {
        const int bh = task >> 12, e0 = (task & 4095) * 8;
        unsigned char* base = (unsigned char*)p.out + (size_t)bh * 32 * 65536 + (size_t)e0 * 2;
        float C[8];
#pragma unroll
        for (int j = 0; j < 8; ++j) C[j] = 0.f;
#pragma unroll 1
        for (int nb = 0; nb < 32; nb += 8) {
            u32x4 kv[8];
#pragma unroll
            for (int i = 0; i < 8; ++i) kv[i] = __builtin_nontemporal_load((const u32x4*)(base + (size_t)(nb + i) * 65536));
#pragma unroll
            for (int i = 0; i < 8; ++i) {
                u32x4 w; w.x = pk_bf16(C[0], C[1]); w.y = pk_bf16(C[2], C[3]); w.z = pk_bf16(C[4], C[5]); w.w = pk_bf16(C[6], C[7]);
                *(u32x4*)(base + (W_MLCS - W_MLKV) + (size_t)(nb + i) * 65536) = w;
                const float cs = sc[(size_t)(bh * 32 + nb + i) * 4];
                C[0] = cs * C[0] + bf_lo(kv[i].x); C[1] = cs * C[1] + bf_hi(kv[i].x); C[2] = cs * C[2] + bf_lo(kv[i].y); C[3] = cs * C[3] + bf_hi(kv[i].y);
                C[4] = cs * C[4] + bf_lo(kv[i].z); C[5] = cs * C[5] + bf_hi(kv[i].z); C[6] = cs * C[6] + bf_lo(kv[i].w); C[7] = cs * C[7] + bf_hi(kv[i].w);
            }
        }
        const int dv = e0 >> 7, k0 = e0 & 127;
        float* co = p.out + O_P_MLC + (size_t)bh * 32768 + (size_t)k0 * 256 + dv;
#pragma unroll
        for (int j = 0; j < 8; ++j) co[j * 256] = C[j];
    }
    for (int task = wk * 512 + tid; task < 2048; task += NW * 512) {
        const int bh = task >> 7, kd = task & 127;
        const float* mn = (const float*)(ws + W_MLN) + (size_t)bh * 32 * 128 + kd;
        float* ms = (float*)(ws + W_MLNS) + (size_t)bh * 32 * 128 + kd;
        float nn = 0.f;
#pragma unroll 1
        for (int n = 0; n < 32; ++n) { const float kn = mn[n * 128]; ms[n * 128] = nn; nn = sc[(size_t)(bh * 32 + n) * 4] * nn + kn; }
        p.out[O_P_MLN + (size_t)bh * 128 + kd] = nn;
        if (kd == 0) p.out[O_P_MLM + bh] = sc[(size_t)(bh * 32 + 31) * 4 + 2];
    }
}

__device__ __forceinline__ void ml_passC(const Params& p, LAS unsigned char* lds, int item) {
    const int tid = opaque_tid(), wave = tid >> 6, lane = tid & 63, fr = lane & 15, fq = lane >> 4;
    const int n = item & 31, bh = item >> 5, h = bh & 3, b = bh >> 2, tok0 = b * SEQL + n * 64;
    unsigned char* ws = p.ws;
    const bf16_t* proj = (const bf16_t*)(ws + W_PROJ); bf16_t* mix = (bf16_t*)(ws + W_MIX); const float* gates = (const float*)(ws + W_GATES);
    constexpr int L_QS = 0, L_KN = 17408, L_VT = 34816, L_S = 71680, L_SM = 80896, L_O = 0;
    LAS float* s_a = (LAS float*)(lds + L_SM); LAS float* s_M = s_a + 64; LAS float* s_int = s_a + 128; LAS float* s_emn = s_a + 192; LAS float* s_hd = s_a + 256;
    const float ib = p.in[14][h], fb = p.in[15][h];
    const float m_prev = ((const float*)(ws + W_MLSC))[(size_t)item * 4 + 1];
    const MlGate g = ml_gates(gates, tok0, lane, h, fb, ib, m_prev);
    if (wave == 0) { s_a[lane] = g.av; s_M[lane] = g.Mi; s_int[lane] = __expf(m_prev - g.Mi) * 0.08838834764831845f; s_emn[lane] = __expf(-(g.bc + g.Mi)); }
    const int lr = tid >> 3, lp = tid & 7;
    u32x4 zpre[4];
#pragma unroll
    for (int i = 0; i < 4; ++i) zpre[i] = *(const u32x4*)(proj + (size_t)(tok0 + (tid >> 3)) * PCOL + PC_MLO + h * 256 + (tid & 7) * 32 + 8 * i);
    {
        const bf16_t* rp = proj + (size_t)(tok0 + lr) * PCOL;
        const u32x4 pq0 = *(const u32x4*)(rp + PC_MLQ + h * 128 + lp * 16), pq1 = *(const u32x4*)(rp + PC_MLQ + h * 128 + lp * 16 + 8);
        const u32x4 pk0 = *(const u32x4*)(rp + PC_MLK + h * 128 + lp * 16), pk1 = *(const u32x4*)(rp + PC_MLK + h * 128 + lp * 16 + 8);
        u32x4 pv[4];
#pragma unroll
        for (int i = 0; i < 4; ++i) pv[i] = *(const u32x4*)(rp + PC_MLV + h * 256 + lp * 32 + i * 8);
        *(LAS u32x4*)(lds + L_QS + lr * 272 + lp * 32) = pq0; *(LAS u32x4*)(lds + L_QS + lr * 272 + lp * 32 + 16) = pq1;
        *(LAS u32x4*)(lds + L_KN + lr * 272 + lp * 32) = pk0; *(LAS u32x4*)(lds + L_KN + lr * 272 + lp * 32 + 16) = pk1;
#pragma unroll
        for (int i = 0; i < 4; ++i) { const unsigned vw[4] = {pv[i].x, pv[i].y, pv[i].z, pv[i].w};
#pragma unroll
            for (int e = 0; e < 4; ++e) {
                *(LAS bf16_t*)(lds + L_VT + (lp * 32 + i * 8 + 2 * e) * 144 + lr * 2) = (bf16_t)(vw[e] & 0xffffu);
                *(LAS bf16_t*)(lds + L_VT + (lp * 32 + i * 8 + 2 * e + 1) * 144 + lr * 2) = (bf16_t)(vw[e] >> 16);
            } }
    }
    __syncthreads();
#pragma unroll
    for (int q = 0; q < 2; ++q) {
        const int tt = wave + 8 * q, it = tt >> 2, jt = tt & 3;
        f32x4 acc = {0.f, 0.f, 0.f, 0.f};
        if (jt <= it) {
#pragma unroll
            for (int kk = 0; kk < 4; ++kk) acc = MFMA16(*(const LAS bf16x8*)(lds + L_QS + (16 * it + fr) * 272 + kk * 64 + fq * 16), *(const LAS bf16x8*)(lds + L_KN + (16 * jt + fr) * 272 + kk * 64 + fq * 16), acc);
        }
        const int j = 16 * jt + fr; const float aj = s_a[j];
#pragma unroll
        for (int e = 0; e < 4; ++e) { const int i = 16 * it + 4 * fq + e;
            const float v = (j <= i) ? acc[e] * 0.08838834764831845f * __expf(fminf(aj - s_M[i], 0.f)) : 0.f;
            *(LAS bf16_t*)(lds + L_S + i * 144 + j * 2) = f2bf(v); }
    }
    f32x4 T[4][2];
#pragma unroll
    for (int mt = 0; mt < 4; ++mt) { T[mt][0] = (f32x4){0.f, 0.f, 0.f, 0.f}; T[mt][1] = (f32x4){0.f, 0.f, 0.f, 0.f}; }
    {
        const unsigned char* cb = (const unsigned char*)p.out + 33554432 + (size_t)item * 65536;
#pragma unroll
        for (int kk = 0; kk < 4; ++kk) {
            const bf16x8 Bc0 = *(const bf16x8*)(cb + ((32 * wave + fr) * 128 + 32 * kk + 8 * fq) * 2), Bc1 = *(const bf16x8*)(cb + ((32 * wave + 16 + fr) * 128 + 32 * kk + 8 * fq) * 2);
#pragma unroll
            for (int mt = 0; mt < 4; ++mt) { const bf16x8 a = *(const LAS bf16x8*)(lds + L_QS + (16 * mt + fr) * 272 + kk * 64 + fq * 16);
                T[mt][0] = MFMA16(a, Bc0, T[mt][0]); T[mt][1] = MFMA16(a, Bc1, T[mt][1]); }
        }
#pragma unroll
        for (int mt = 0; mt < 4; ++mt)
#pragma unroll
            for (int e = 0; e < 4; ++e) { const float sc = s_int[16 * mt + 4 * fq + e]; T[mt][0][e] *= sc; T[mt][1][e] *= sc; }
    }
    __syncthreads();
    {
        const int r = tid >> 3, part = tid & 7;
        float qn = 0.f;
        { const u32x4 q0 = *(const LAS u32x4*)(lds + L_QS + r * 272 + part * 32), q1 = *(const LAS u32x4*)(lds + L_QS + r * 272 + part * 32 + 16);
          const float* np = (const float*)(ws + W_MLNS) + (size_t)item * 128 + part * 16;
          const unsigned qw[8] = {q0.x, q0.y, q0.z, q0.w, q1.x, q1.y, q1.z, q1.w};
#pragma unroll
          for (int e = 0; e < 8; ++e) qn += bf_lo(qw[e]) * np[2 * e] + bf_hi(qw[e]) * np[2 * e + 1]; }
        float rs = 0.f;
        { const u32x4 s0 = *(const LAS u32x4*)(lds + L_S + r * 144 + part * 16);
          rs = bf_lo(s0.x) + bf_hi(s0.x) + bf_lo(s0.y) + bf_hi(s0.y) + bf_lo(s0.z) + bf_hi(s0.z) + bf_lo(s0.w) + bf_hi(s0.w); }
        float den = s_int[r] * qn + rs;
        den += __shfl_xor(den, 1); den += __shfl_xor(den, 2); den += __shfl_xor(den, 4);
        if (part == 0) s_hd[r] = __builtin_amdgcn_rcpf(fmaxf(fabsf(den), s_emn[r]));
    }
    {
        bf16x8 Bv[2][2];
#pragma unroll
        for (int kc = 0; kc < 2; ++kc)
#pragma unroll
            for (int nt = 0; nt < 2; ++nt) Bv[kc][nt] = *(const LAS bf16x8*)(lds + L_VT + (32 * wave + 16 * nt + fr) * 144 + kc * 64 + fq * 16);
#pragma unroll
        for (int mt = 0; mt < 4; ++mt)
#pragma unroll
            for (int kc = 0; kc < 2; ++kc) { const bf16x8 a = *(const LAS bf16x8*)(lds + L_S + (16 * mt + fr) * 144 + kc * 64 + fq * 16);
                T[mt][0] = MFMA16(a, Bv[kc][0], T[mt][0]); T[mt][1] = MFMA16(a, Bv[kc][1], T[mt][1]); }
    }
    __syncthreads();
#pragma unroll
    for (int mt = 0; mt < 4; ++mt)
#pragma unroll
        for (int e = 0; e < 4; ++e) { const int i = 16 * mt + 4 * fq + e; const float hd = s_hd[i];
            ((LAS float*)(lds + L_O))[i * 260 + 32 * wave + fr] = T[mt][0][e] * hd; ((LAS float*)(lds + L_O))[i * 260 + 32 * wave + 16 + fr] = T[mt][1][e] * hd; }
    __syncthreads();
    {
        const int c = tid >> 3, part = tid & 7, row = tok0 + c;
        const LAS float* op = (const LAS float*)(lds + L_O) + c * 260 + part * 32;
        f32x4 v[8]; float ss = 0.f;
#pragma unroll
        for (int i = 0; i < 8; ++i) { v[i] = *(const LAS f32x4*)(op + 4 * i); ss += v[i][0] * v[i][0] + v[i][1] * v[i][1] + v[i][2] * v[i][2] + v[i][3] * v[i][3]; }
        ss += __shfl_xor(ss, 1); ss += __shfl_xor(ss, 2); ss += __shfl_xor(ss, 4);
        const float rn = rsqrtf(ss * (1.f / 256.f) + EPS);
        const bf16_t* zp = proj + (size_t)row * PCOL + PC_MLO + h * 256 + part * 32;
        const float* gp = p.in[16] + h * 256 + part * 32;
        bf16_t* mp = mix + (size_t)row * DM + 1024 + h * 256 + part * 32;
#pragma unroll
        for (int i = 0; i < 4; ++i) {
            const u32x4 z = zpre[i];
            const float zz[8] = {bf_lo(z.x), bf_hi(z.x), bf_lo(z.y), bf_hi(z.y), bf_lo(z.z), bf_hi(z.z), bf_lo(z.w), bf_hi(z.w)};
            float o[8];
#pragma unroll
            for (int e = 0; e < 8; ++e) o[e] = v[2 * i + (e >> 2)][e & 3] * rn * gp[8 * i + e] * sigm(zz[e]);
            u32x4 w; w.x = pk_bf16(o[0], o[1]); w.y = pk_bf16(o[2], o[3]); w.z = pk_bf16(o[4], o[5]); w.w = pk_bf16(o[6], o[7]);
            *(u32x4*)(mp + 8 * i) = w;
        }
    }
    __syncthreads();
}

__device__ __forceinline__ void sample_dn(const Params& p, LAS unsigned char* lds, int iter) {
    const int tid = opaque_tid(), sub = tid >> 7, j = tid & 127, wv = (tid >> 6) & 1, lane = tid & 63;
    const int item = iter * 4 + sub, s = item >> 3, h = item & 7;
    unsigned char* ws = p.ws;
    const bf16_t* proj = (const bf16_t*)(ws + W_PROJ); bf16_t* mix = (bf16_t*)(ws + W_MIX); const float* gates = (const float*)(ws + W_GATES);
    LAS float* sq = (LAS float*)(lds + sub * 24576); LAS float* sk = sq + 1024; LAS float* sv = sq + 2048; LAS float* so = sq + 3072; LAS float* sz = sq + 4096;
    LAS float* red = sq + 5120;   LAS float* sg = sq + 5152;
    const int row0 = NPT + 8 * s;
#pragma unroll
    for (int t = 0; t < 8; ++t) sz[t * 128 + j] = bf2f(proj[(size_t)(row0 + t) * PCOL + PC_DNZ + h * 128 + j]);
    float qv[8], kv[8];
#pragma unroll
    for (int sec = 0; sec < 3; ++sec) {
        const int c = sec * 1024 + h * 128 + j;
        float xp[11];
#pragma unroll
        for (int i = 0; i < 3; ++i) xp[i] = p.in[2][(size_t)(s * 3 + i) * 3072 + c];
#pragma unroll
        for (int t = 0; t < 8; ++t) xp[3 + t] = bf2f(proj[(size_t)(row0 + t) * PCOL + c]);
        const float w0 = p.in[10][c], w1 = p.in[10][3072 + c], w2 = p.in[10][6144 + c], w3 = p.in[10][9216 + c];
#pragma unroll
        for (int t = 0; t < 8; ++t) { const float v = siluf(w0 * xp[t] + w1 * xp[t + 1] + w2 * xp[t + 2] + w3 * xp[t + 3]);
            if (sec == 0) qv[t] = v; else if (sec == 1) kv[t] = v; else sv[t * 128 + j] = v; }
    }
    {
        float ra[8], rb[8];
#pragma unroll
        for (int t = 0; t < 8; ++t) { ra[t] = qv[t] * qv[t]; rb[t] = kv[t] * kv[t]; }
#pragma unroll
        for (int d = 32; d >= 1; d >>= 1) {
#pragma unroll
            for (int t = 0; t < 8; ++t) { ra[t] += __shfl_xor(ra[t], d); rb[t] += __shfl_xor(rb[t], d); }
        }
        if (lane == 0) {
#pragma unroll
            for (int t = 0; t < 8; ++t) { red[wv * 16 + t] = ra[t]; red[wv * 16 + 8 + t] = rb[t]; }
        }
    }
    if (j < 8) { const int row = row0 + j;
        sg[2 * j] = __expf(-__expf(p.in[11][h]) * softplusf(gates[(size_t)row * 32 + 8 + h] + p.in[12][h]));
        sg[2 * j + 1] = sigm(gates[(size_t)row * 32 + h]); }
    __syncthreads();
#pragma unroll
    for (int t = 0; t < 8; ++t) {
        sq[t * 128 + j] = qv[t] * rsqrtf(red[t] + red[16 + t] + EPS) * 0.08838834764831845f;
        sk[t * 128 + j] = kv[t] * rsqrtf(red[8 + t] + red[24 + t] + EPS);
    }
    float S[128];
    const float* sp = p.in[3] + ((size_t)(s * 8 + h) * 128) * 128 + j;
#pragma unroll
    for (int k = 0; k < 128; ++k) S[k] = __builtin_nontemporal_load(sp + (size_t)k * 128);
    __syncthreads();
#pragma unroll 1
    for (int t = 0; t < 8; ++t) {
        const float a = sg[2 * t], be = sg[2 * t + 1], vt = sv[t * 128 + j];
        float kvs = 0.f;
#pragma unroll
        for (int k4 = 0; k4 < 32; ++k4) { const f32x4 kk = *(const LAS f32x4*)(sk + t * 128 + 4 * k4);
            kvs += S[4 * k4] * kk[0] + S[4 * k4 + 1] * kk[1] + S[4 * k4 + 2] * kk[2] + S[4 * k4 + 3] * kk[3];
            if ((k4 & 7) == 7) __builtin_amdgcn_sched_barrier(0); }
        const float delta = be * (vt - a * kvs);
        float o = 0.f;
#pragma unroll
        for (int k4 = 0; k4 < 32; ++k4) { const f32x4 kk = *(const LAS f32x4*)(sk + t * 128 + 4 * k4), qq = *(const LAS f32x4*)(sq + t * 128 + 4 * k4);
#pragma unroll
            for (int e = 0; e < 4; ++e) { S[4 * k4 + e] = a * S[4 * k4 + e] + kk[e] * delta; o += S[4 * k4 + e] * qq[e]; }
            if ((k4 & 3) == 3) __builtin_amdgcn_sched_barrier(0); }
        so[t * 128 + j] = o;
    }
    float* dp = p.out + O_S_DNS + ((size_t)(s * 8 + h) * 128) * 128 + j;
#pragma unroll
    for (int k = 0; k < 128; ++k) __builtin_nontemporal_store(S[k], dp + (size_t)k * 128);
    float ov[8];
    {
        float ra[8];
#pragma unroll
        for (int t = 0; t < 8; ++t) { ov[t] = so[t * 128 + j]; ra[t] = ov[t] * ov[t]; }
#pragma unroll
        for (int d = 32; d >= 1; d >>= 1) {
#pragma unroll
            for (int t = 0; t < 8; ++t) ra[t] += __shfl_xor(ra[t], d);
        }
        if (lane == 0) {
#pragma unroll
            for (int t = 0; t < 8; ++t) red[wv * 16 + t] = ra[t];
        }
    }
    __syncthreads();
    const float gn = p.in[13][j];
#pragma unroll
    for (int t = 0; t < 8; ++t) {
        const float rn = rsqrtf((red[t] + red[16 + t]) * (1.f / 128.f) + EPS);
        mix[(size_t)(row0 + t) * DM + h * 128 + j] = f2bf(ov[t] * rn * gn * siluf(sz[t * 128 + j]));
    }
    __syncthreads();
}

__device__ __forceinline__ void sample_ml(const Params& p, LAS unsigned char* lds, int iter) {
    const int tid = opaque_tid(), sub = tid >> 8, j = tid & 255, wv = (tid >> 6) & 3, lane = tid & 63;
    const int item = iter * 2 + sub, s = item >> 2, h = item & 3;
    unsigned char* ws = p.ws;
    const bf16_t* proj = (const bf16_t*)(ws + W_PROJ); bf16_t* mix = (bf16_t*)(ws + W_MIX); const float* gates = (const float*)(ws + W_GATES);
    LAS float* sq = (LAS float*)(lds + sub * 40960); LAS float* sk = sq + 1024; LAS float* sv = sq + 2048;   LAS float* sh = sq + 4096;
    LAS float* sz = sq + 6144;   LAS float* red = sq + 8192;   LAS float* sgt = sq + 8224;   LAS float* sgr = sq + 8256;
    const int row0 = NPT + 8 * s;
#pragma unroll
    for (int t = 0; t < 8; ++t) sz[t * 256 + j] = bf2f(proj[(size_t)(row0 + t) * PCOL + PC_MLO + h * 256 + j]);
    if (j < 8) { sgr[2 * j] = logsigm(gates[(size_t)(row0 + j) * 32 + 20 + h] + p.in[15][h]); sgr[2 * j + 1] = gates[(size_t)(row0 + j) * 32 + 16 + h] + p.in[14][h]; }
    if (j < 128) {
#pragma unroll
        for (int t = 0; t < 8; ++t) {
            sq[t * 128 + j] = bf2f(proj[(size_t)(row0 + t) * PCOL + PC_MLQ + h * 128 + j]) * 0.08838834764831845f;
            sk[t * 128 + j] = bf2f(proj[(size_t)(row0 + t) * PCOL + PC_MLK + h * 128 + j]);
        }
    }
#pragma unroll
    for (int t = 0; t < 8; ++t) sv[t * 256 + j] = bf2f(proj[(size_t)(row0 + t) * PCOL + PC_MLV + h * 256 + j]);
    float Cc[128];
    const float* cp = p.in[4] + ((size_t)(s * 4 + h) * 128) * 256 + j;
#pragma unroll
    for (int k = 0; k < 128; ++k) Cc[k] = __builtin_nontemporal_load(cp + (size_t)k * 256);
    float nj = 0.f;
    if (j < 128) nj = p.in[5][(size_t)(s * 4 + h) * 128 + j];
    const float m0 = p.in[6][s * 4 + h];
    __syncthreads();
    {
        float pd[8]; float m = m0;
#pragma unroll
        for (int t = 0; t < 8; ++t) {
            const float f = sgr[2 * t], ig = sgr[2 * t + 1];
            const float mn = fmaxf(f + m, ig), fp = __expf(f + m - mn), ip = __expf(ig - mn);
            if (j == 0) { sgt[4 * t] = fp; sgt[4 * t + 1] = ip; sgt[4 * t + 2] = __expf(-mn); sgt[4 * t + 3] = mn; }
            m = mn;
            pd[t] = 0.f;
            if (j < 128) { nj = fp * nj + ip * sk[t * 128 + j]; pd[t] = nj * sq[t * 128 + j]; }
        }
#pragma unroll
        for (int d = 32; d >= 1; d >>= 1) {
#pragma unroll
            for (int t = 0; t < 8; ++t) pd[t] += __shfl_xor(pd[t], d);
        }
        if (lane == 0) {
#pragma unroll
            for (int t = 0; t < 8; ++t) red[wv * 8 + t] = pd[t];
        }
    }
    __syncthreads();
#pragma unroll 1
    for (int t = 0; t < 8; ++t) {
        const float f = sgt[4 * t], iv = sgt[4 * t + 1] * sv[t * 256 + j];
        float num = 0.f;
#pragma unroll
        for (int k4 = 0; k4 < 32; ++k4) { const f32x4 kk = *(const LAS f32x4*)(sk + t * 128 + 4 * k4), qq = *(const LAS f32x4*)(sq + t * 128 + 4 * k4);
#pragma unroll
            for (int e = 0; e < 4; ++e) { Cc[4 * k4 + e] = f * Cc[4 * k4 + e] + kk[e] * iv; num += Cc[4 * k4 + e] * qq[e]; }
            if ((k4 & 3) == 3) __builtin_amdgcn_sched_barrier(0); }
        const float den = red[t] + red[8 + t] + red[16 + t] + red[24 + t];
        sh[t * 256 + j] = num * __builtin_amdgcn_rcpf(fmaxf(fabsf(den), sgt[4 * t + 2]));
    }
    float* dp = p.out + O_S_MLC + ((size_t)(s * 4 + h) * 128) * 256 + j;
#pragma unroll
    for (int k = 0; k < 128; ++k) __builtin_nontemporal_store(Cc[k], dp + (size_t)k * 256);
    if (j < 128) p.out[O_S_MLN + (size_t)(s * 4 + h) * 128 + j] = nj;
    if (j == 0) p.out[O_S_MLM + s * 4 + h] = sgt[31];
    __syncthreads();
    float hv[8];
    {
        float ra[8];
#pragma unroll
        for (int t = 0; t < 8; ++t) { hv[t] = sh[t * 256 + j]; ra[t] = hv[t] * hv[t]; }
#pragma unroll
        for (int d = 32; d >= 1; d >>= 1) {
#pragma unroll
            for (int t = 0; t < 8; ++t) ra[t] += __shfl_xor(ra[t], d);
        }
        if (lane == 0) {
#pragma unroll
            for (int t = 0; t < 8; ++t) red[wv * 8 + t] = ra[t];
        }
    }
    __syncthreads();
    const float gn = p.in[16][h * 256 + j];
#pragma unroll
    for (int t = 0; t < 8; ++t) {
        const float rn = rsqrtf((red[t] + red[8 + t] + red[16 + t] + red[24 + t]) * (1.f / 256.f) + EPS);
        mix[(size_t)(row0 + t) * DM + 1024 + h * 256 + j] = f2bf(hv[t] * rn * gn * sigm(sz[t * 256 + j]));
    }
    __syncthreads();
}

__device__ __forceinline__ void phase6(const Params& p) {
    const int tid = opaque_tid();
    unsigned char* ws = p.ws;
    const bf16_t* u = (const bf16_t*)(ws + W_PROJ); bf16_t* act = (bf16_t*)(ws + W_WIN);
    const float* cw = p.in[20]; const float* cb = p.in[21]; const float* st = p.in[7];
    const int gt = blockIdx.x * 512 + tid, GT = gridDim.x * 512;
    for (int task = gt; task < 144 * 704; task += GT) {
        const int cgp = task % 704, chunk = task / 704, R0 = chunk * 64, c0 = cgp * 8;
        const bool smp = R0 >= NPT;
        f32x4 wg[3][2], wu[3][2], bgv[2], buv[2];
#pragma unroll
        for (int jj = 0; jj < 3; ++jj) { wg[jj][0] = *(const f32x4*)(cw + (size_t)jj * FF2 + c0); wg[jj][1] = *(const f32x4*)(cw + (size_t)jj * FF2 + c0 + 4);
            wu[jj][0] = *(const f32x4*)(cw + (size_t)jj * FF2 + FF + c0); wu[jj][1] = *(const f32x4*)(cw + (size_t)jj * FF2 + FF + c0 + 4); }
        bgv[0] = *(const f32x4*)(cb + c0); bgv[1] = *(const f32x4*)(cb + c0 + 4); buv[0] = *(const f32x4*)(cb + FF + c0); buv[1] = *(const f32x4*)(cb + FF + c0 + 4);
        u32x4 xg[10], xu[10];
        if (!smp && (R0 % SEQL) != 0) {
#pragma unroll
            for (int i = 0; i < 2; ++i) { const bf16_t* rp = u + (size_t)(R0 - 2 + i) * FF2 + c0; xg[i] = *(const u32x4*)rp; xu[i] = *(const u32x4*)(rp + FF); }
        } else {
#pragma unroll
            for (int i = 0; i < 2; ++i) { xg[i] = (u32x4){0u, 0u, 0u, 0u}; xu[i] = (u32x4){0u, 0u, 0u, 0u}; }
        }
#pragma unroll 1
        for (int run = 0; run < 8; ++run) {
            const int row0 = R0 + 8 * run;
#pragma unroll
            for (int i = 2; i < 10; ++i) { const bf16_t* rp = u + (size_t)(row0 - 2 + i) * FF2 + c0; xg[i] = *(const u32x4*)rp; xu[i] = *(const u32x4*)(rp + FF); }
            if (smp) {
#pragma unroll
                for (int i = 0; i < 2; ++i) {
                    const float* sp = st + ((size_t)((row0 - NPT) >> 3) * 2 + i) * FF2 + c0;
                    xg[i] = pack8(*(const f32x4*)sp, *(const f32x4*)(sp + 4)); xu[i] = pack8(*(const f32x4*)(sp + FF), *(const f32x4*)(sp + FF + 4));
                }
            }
#define CVL(v) ((f32x4){bf_lo((v).x), bf_hi((v).x), bf_lo((v).y), bf_hi((v).y)})
#define CVH(v) ((f32x4){bf_lo((v).z), bf_hi((v).z), bf_lo((v).w), bf_hi((v).w)})
            {
                f32x4 ga0 = CVL(xg[0]), ga1 = CVH(xg[0]), gb0 = CVL(xg[1]), gb1 = CVH(xg[1]);
                f32x4 ua0 = CVL(xu[0]), ua1 = CVH(xu[0]), ub0 = CVL(xu[1]), ub1 = CVH(xu[1]);
#pragma unroll
                for (int r = 0; r < 8; ++r) {
                    const f32x4 gc0 = CVL(xg[r + 2]), gc1 = CVH(xg[r + 2]), uc0 = CVL(xu[r + 2]), uc1 = CVH(xu[r + 2]);
                    const f32x4 g0 = bgv[0] + wg[0][0] * ga0 + wg[1][0] * gb0 + wg[2][0] * gc0;
                    const f32x4 g1 = bgv[1] + wg[0][1] * ga1 + wg[1][1] * gb1 + wg[2][1] * gc1;
                    const f32x4 u0 = buv[0] + wu[0][0] * ua0 + wu[1][0] * ub0 + wu[2][0] * uc0;
                    const f32x4 u1 = buv[1] + wu[0][1] * ua1 + wu[1][1] * ub1 + wu[2][1] * uc1;
                    u32x4 w; w.x = pk_bf16(siluf(g0[0]) * u0[0], siluf(g0[1]) * u0[1]); w.y = pk_bf16(siluf(g0[2]) * u0[2], siluf(g0[3]) * u0[3]);
                    w.z = pk_bf16(siluf(g1[0]) * u1[0], siluf(g1[1]) * u1[1]); w.w = pk_bf16(siluf(g1[2]) * u1[2], siluf(g1[3]) * u1[3]);
                    *(u32x4*)(act + (size_t)(row0 + r) * FF + c0) = w;
                    ga0 = gb0; ga1 = gb1; gb0 = gc0; gb1 = gc1; ua0 = ub0; ua1 = ub1; ub0 = uc0; ub1 = uc1;
                }
            }
#undef CVL
#undef CVH
            xg[0] = xg[8]; xg[1] = xg[9]; xu[0] = xu[8]; xu[1] = xu[9];
        }
    }
    float* out = p.out;
    for (int i = gt; i < 128 * 2 * FF2; i += GT) { const int c = i % FF2, j = (i / FF2) & 1, s = i / (2 * FF2);
        out[O_S_FFN + i] = bf2f(u[(size_t)(NPT + 8 * s + 6 + j) * FF2 + c]); }
    for (int i = gt; i < 4 * 2 * FF2; i += GT) { const int c = i % FF2, j = (i / FF2) & 1, b = i / (2 * FF2);
        out[O_P_FFN + i] = bf2f(u[(size_t)(b * SEQL + 2046 + j) * FF2 + c]); }
}

__device__ __forceinline__ void phase8(const Params& p) {
    const int tid = opaque_tid(), wave = tid >> 6, lane = tid & 63;
    const float* p1 = (const float*)(p.ws + W_PROJ); const float* g = p.in[23];
    float* y = p.out + O_Y;
    for (int row = blockIdx.x * 8 + wave; row < NTOK; row += gridDim.x * 8) {
        float* yr = y + (size_t)row * DM; const float* pr = p1 + (size_t)row * DM;
        f32x4 v[8]; float ss = 0.f;
#pragma unroll
        for (int i = 0; i < 8; ++i) { const int c = i * 256 + lane * 4; v[i] = *(const f32x4*)(yr + c) + *(const f32x4*)(pr + c);
            ss += v[i][0] * v[i][0] + v[i][1] * v[i][1] + v[i][2] * v[i][2] + v[i][3] * v[i][3]; }
        ss = wave_sum(ss);
        const float rn = rsqrtf(ss * (1.f / 2048.f) + EPS);
#pragma unroll
        for (int i = 0; i < 8; ++i) { const int c = i * 256 + lane * 4; const f32x4 gg = *(const f32x4*)(g + c);
            __builtin_nontemporal_store((f32x4){v[i][0] * rn * gg[0], v[i][1] * rn * gg[1], v[i][2] * rn * gg[2], v[i][3] * rn * gg[3]}, (f32x4*)(yr + c)); }
    }
}

#define XB_TMO      128
#define XB_XCNT(j)  (256  + 64 * (j))
#define XB_XSUB(j)  (1280 + 64 * (j))
#define XB_XGEN(j)  (2304 + 64 * (j))
#define XB_TOP      3328
#define XB_TOPGEN   3392
#define XCD_BAR_WORDS 3456
#define XB_SPIN_CAP (1u << 18)

__device__ __forceinline__ unsigned xb_ld(unsigned* p)              { return __hip_atomic_load(p, __ATOMIC_RELAXED, __HIP_MEMORY_SCOPE_AGENT); }
__device__ __forceinline__ unsigned xb_add(unsigned* p, unsigned v) { return __hip_atomic_fetch_add(p, v, __ATOMIC_RELAXED, __HIP_MEMORY_SCOPE_AGENT); }
__device__ __forceinline__ unsigned xb_xcc_id() { return (unsigned)__builtin_amdgcn_s_getreg((3 << 11) | 20) & 0xFu; }
#define XB_SPIN(cond, bar) do { unsigned _sp = 0; while (cond) { __builtin_amdgcn_s_sleep(1); \
    if ((++_sp & 255u) == 0u) { if (xb_ld(&(bar)[XB_TMO])) break; if (_sp > XB_SPIN_CAP) { atomicAdd(&(bar)[XB_TMO], 1u); break; } } } } while (0)

struct XcdBarrier {
    unsigned* bar; unsigned x;
    volatile LAS unsigned* st;
};

__device__ __forceinline__ XcdBarrier xcd_barrier_post(unsigned* bar, volatile LAS unsigned* st) {
    XcdBarrier b; b.bar = bar; b.x = xb_xcc_id(); b.st = st;
    if (threadIdx.x == 0) (void)xb_add(&bar[XB_XCNT(b.x)], 1u);
    return b;
}
__device__ __forceinline__ void xcd_barrier_complete(unsigned* bar, unsigned x, unsigned& nloc, unsigned& nx) {
    const unsigned G = gridDim.x * gridDim.y * gridDim.z;
    unsigned sum, cnt, mine, sp = 0u;
    for (;;) {
        sum = 0u; cnt = 0u; mine = 0u;
#pragma unroll
        for (unsigned j = 0; j < 16; ++j) { const unsigned c = xb_ld(&bar[XB_XCNT(j)]); sum += c; cnt += (c > 0u) ? 1u : 0u; mine = (j == x) ? c : mine; }
        if (sum == G) break;
        __builtin_amdgcn_s_sleep(1);
        if ((++sp & 255u) == 0u) { if (xb_ld(&bar[XB_TMO])) break; if (sp > XB_SPIN_CAP) { atomicAdd(&bar[XB_TMO], 1u); break; } }
    }
    nloc = mine > 0u ? mine : 1u; nx = cnt > 0u ? cnt : 1u;
}

__device__ __forceinline__ void xcd_barrier(const XcdBarrier& b) {
    asm volatile("s_waitcnt vmcnt(0)" ::: "memory");
    __syncthreads();
    if (threadIdx.x == 0) {
        unsigned* bar = b.bar;
        __builtin_amdgcn_s_waitcnt(0);
        unsigned nloc = b.st[0], nx = b.st[1];
        if (nloc == 0u) { xcd_barrier_complete(bar, b.x, nloc, nx); b.st[0] = nloc; b.st[1] = nx; }
        const unsigned old = xb_add(&bar[XB_XSUB(b.x)], 1u);
        const unsigned gen = old / nloc;
        if (old + 1u == (gen + 1u) * nloc) {
            __builtin_amdgcn_fence(__ATOMIC_RELEASE, "agent");
            asm volatile("s_waitcnt vmcnt(0)" ::: "memory");
            const unsigned og = xb_add(&bar[XB_TOP], 1u);
            const unsigned tg = og / nx;
            if (og + 1u == (tg + 1u) * nx) xb_add(&bar[XB_TOPGEN], 1u);
            else XB_SPIN(xb_ld(&bar[XB_TOPGEN]) == tg, bar);
            __builtin_amdgcn_fence(__ATOMIC_ACQUIRE, "agent");
            xb_add(&bar[XB_XGEN(b.x)], 1u);
            asm volatile("s_waitcnt vmcnt(0)" ::: "memory");
        } else {
            XB_SPIN(xb_ld(&bar[XB_XGEN(b.x)]) == gen, bar);
            __builtin_amdgcn_fence(__ATOMIC_ACQUIRE, "agent");
            asm volatile("s_waitcnt vmcnt(0)" ::: "memory");
        }
    }
    __syncthreads();
}


#define GSYNC() do { asm volatile("s_waitcnt vmcnt(0)" ::: "memory"); grid.sync(); } while (0)
extern __shared__ __attribute__((aligned(16))) unsigned char smem_raw[];

__global__ void __launch_bounds__(512) hymba_fwd(Params p) {
    cg::grid_group grid = cg::this_grid();
    LAS unsigned char* lds = (LAS unsigned char*)smem_raw;
    unsigned char* ws = p.ws;
    pg8::StaticOrder so;
    unsigned* xbar = (unsigned*)(ws + W_BAR);
    volatile LAS unsigned* xst = (volatile LAS unsigned*)(lds + LDS_BYTES - 16);
    if (blockIdx.x == 0) for (int i = threadIdx.x; i < XCD_BAR_WORDS; i += 512) xbar[i] = 0u;
    if (threadIdx.x == 0) { xst[0] = 0u; xst[1] = 0u; }
    __syncthreads();
    GSYNC();
    const XcdBarrier xb = xcd_barrier_post(xbar, xst);
#define XSYNC() xcd_barrier(xb)
    phase0(p, lds);
    XSYNC();
    for (int rep = 0; rep <= DUP_P1; ++rep) {
        so.init(NTOK, PCOL, gridDim.x, blockIdx.x);
        pg8::Gemm g{(const bf16_t*)(ws + W_XB), (const bf16_t*)(ws + W_WIN), NTOK, PCOL, DM, DM, 1};
        EpiScaleBf16<false> e{(bf16_t*)(ws + W_PROJ), PCOL, (const float*)(ws + W_RSTD1)};
        pg8::gemm_phase(lds, g, so, e);
    XSYNC();
    }
    for (int rep = 0; rep <= DUP_P2; ++rep) {
    phase2(p, lds);
    for (int item = blockIdx.x; item < 512; item += gridDim.x) ml_passA(p, lds, item);
    XSYNC();
    }
    {
        const int blk = blockIdx.x;
        unsigned* cdone = (unsigned*)(ws + W_CTR);
        if (blk < 32) scan_dn(p, lds, blk);
        else {
            const int wk = blk - 32, NW = gridDim.x - 32;
            const int npb = NW < 128 ? NW : 128;
            ml_passB(p, wk, NW);
            if (wk < npb) signal_done(cdone + 32);
            for (int it = wk; it < 512; it += NW) { if (it < 256) sample_dn(p, lds, it); else sample_ml(p, lds, it - 256); }
            signal_done(cdone + 48);
            wait_count(cdone + 32, (unsigned)npb);
            for (int item = wk; item < 512; item += NW) ml_passC(p, lds, item);
            if (wk >= 64 && wk < 96) {
                wait_count(cdone + 48, (unsigned)NW);
                pg8::OneUnit ou{32 + ((wk - 64) >> 3), (wk - 64) & 7};
                pg8::Gemm g{(const bf16_t*)(ws + W_MIX), (const bf16_t*)(ws + W_WOUT), NTOK, DM, DM, DM, 1};
                EpiResid e{p.in[0], p.in[1], p.out + O_Y, (bf16_t*)(ws + W_XB), (float*)(ws + W_SSP2), nullptr};
                pg8::gemm_phase(lds, g, ou, e);
            }
        }
        convert_late(p);
    }
    XSYNC();
    {
        so.init(NPT, DM, gridDim.x, blockIdx.x);
        pg8::Gemm g{(const bf16_t*)(ws + W_MIX), (const bf16_t*)(ws + W_WOUT), NPT, DM, DM, DM, 1};
        EpiResid e{p.in[0], p.in[1], p.out + O_Y, (bf16_t*)(ws + W_XB), (float*)(ws + W_SSP2), nullptr};
        pg8::gemm_phase(lds, g, so, e);
    }
    XSYNC();
    for (int rep = 0; rep <= DUP_P5; ++rep) {
        so.init(NTOK, FF2, gridDim.x, blockIdx.x);
        pg8::Gemm g{(const bf16_t*)(ws + W_XB), (const bf16_t*)(ws + W_WUP), NTOK, FF2, DM, DM, 1};
        EpiScaleBf16<true> e{(bf16_t*)(ws + W_PROJ), FF2, (const float*)(ws + W_SSP2)};
        pg8::gemm_phase(lds, g, so, e);
    XSYNC();
    }
    for (int rep = 0; rep <= DUP_P6; ++rep) {
    phase6(p);
    XSYNC();
    }
    {
        so.init(NTOK, 2 * DM, gridDim.x, blockIdx.x);
        pg8::Gemm g{(const bf16_t*)(ws + W_WIN), (const bf16_t*)(ws + W_WDOWN), NTOK, DM, FF / 2, FF, 2};
        EpiResid e{p.out + O_Y, p.out + O_Y + (size_t)NPT * DM, p.out + O_Y, nullptr, nullptr, (float*)(ws + W_PROJ)};
        pg8::gemm_phase(lds, g, so, e);
    }
    XSYNC();
    phase8(p);
}

extern "C" void kernel_launch(void* const* d_in, const int* in_sizes, int n_in, void* d_out, int out_size, void* d_ws, size_t ws_size, hipStream_t stream) {
    static int grid_blocks = 0;
    if (grid_blocks == 0) {
        if (n_in != 24 || (size_t)out_size != O_TOTAL || ws_size < W_END2) { fprintf(stderr, "kernel_launch: unexpected shapes (n_in %d out %d ws %zu need %zu)\n", n_in, out_size, ws_size, (size_t)W_END2); grid_blocks = -1; return; }
        int dev = 0, cus = 0, per_cu = 0;
        hipGetDevice(&dev);
        hipDeviceGetAttribute(&cus, hipDeviceAttributeMultiprocessorCount, dev);
        if (hipFuncSetAttribute((const void*)hymba_fwd, hipFuncAttributeMaxDynamicSharedMemorySize, LDS_BYTES) != hipSuccess) { fprintf(stderr, "hipFuncSetAttribute failed\n"); grid_blocks = -1; return; }
        if (hipOccupancyMaxActiveBlocksPerMultiprocessor(&per_cu, (const void*)hymba_fwd, 512, LDS_BYTES) != hipSuccess || per_cu < 1) { fprintf(stderr, "occupancy query failed\n"); grid_blocks = -1; return; }
        grid_blocks = cus * (per_cu > 1 ? 1 : per_cu);
    }
    if (grid_blocks < 0) return;
    Params p{};
    for (int i = 0; i < 24; ++i) p.in[i] = (const float*)d_in[i];
    p.out = (float*)d_out; p.ws = (unsigned char*)d_ws;
    void* args[] = {&p};
    hipError_t e = hipLaunchCooperativeKernel((const void*)hymba_fwd, dim3(grid_blocks), dim3(512), args, LDS_BYTES, stream);
    if (e != hipSuccess) fprintf(stderr, "cooperative launch failed: %s (grid %d)\n", hipGetErrorString(e), grid_blocks);
}
```

```cpp
#include <hip/hip_runtime.h>
#include <hip/hip_cooperative_groups.h>
#include <cstdio>
namespace cg = cooperative_groups;

#define LAS __attribute__((address_space(3)))
typedef unsigned short bf16_t;
typedef short bf16x8 __attribute__((ext_vector_type(8)));
typedef float f32x4 __attribute__((ext_vector_type(4)));
typedef unsigned u32x4 __attribute__((ext_vector_type(4)));
typedef unsigned u32x2 __attribute__((ext_vector_type(2)));

constexpr int DM = 2048, NTOK = 9216, NPT = 8192, SEQL = 2048;
constexpr int PCOL = 7168, PROJ_COLS = 7192, FF = 5632, FF2 = 11264;
constexpr int PC_DNZ = 3072, PC_MLQ = 4096, PC_MLK = 4608, PC_MLV = 5120, PC_MLO = 6144;
constexpr float EPS = 1e-6f;
constexpr int LDS_BYTES = 139264;
#ifndef DUP_P0
#define DUP_P0 0
#endif
#ifndef DUP_P1
#define DUP_P1 0
#endif
#ifndef DUP_P2
#define DUP_P2 0
#endif
#ifndef DUP_P3
#define DUP_P3 0
#endif
#ifndef DUP_P5
#define DUP_P5 0
#endif
#ifndef DUP_P6
#define DUP_P6 0
#endif

constexpr size_t O_Y = 0;
constexpr size_t O_P_DNCONV = 18874368;
constexpr size_t O_P_DNS = O_P_DNCONV + 36864;
constexpr size_t O_P_MLC = O_P_DNS + 524288;
constexpr size_t O_P_MLN = O_P_MLC + 524288;
constexpr size_t O_P_MLM = O_P_MLN + 2048;
constexpr size_t O_P_FFN = O_P_MLM + 16;
constexpr size_t O_S_DNCONV = O_P_FFN + 90112;
constexpr size_t O_S_DNS = O_S_DNCONV + 1179648;
constexpr size_t O_S_MLC = O_S_DNS + 16777216;
constexpr size_t O_S_MLN = O_S_MLC + 16777216;
constexpr size_t O_S_MLM = O_S_MLN + 65536;
constexpr size_t O_S_FFN = O_S_MLM + 512;
constexpr size_t O_TOTAL = O_S_FFN + 2883584;

constexpr size_t W_PROJ = 0;
constexpr size_t W_ITEMS = 132120576;
constexpr size_t W_WIN = 216006656;
constexpr size_t W_XB = W_WIN + 29360128;
constexpr size_t W_MIX = W_XB + 37748736;
constexpr size_t W_WOUT = W_MIX + 37748736;
constexpr size_t W_WUP = W_WOUT + 8388608;
constexpr size_t W_WDOWN = W_WUP + 46137344;
constexpr size_t W_RSTD1 = W_WDOWN + 23068672;
constexpr size_t W_GATES = W_RSTD1 + 36864;
constexpr size_t W_SSP2 = W_GATES + 1179648;
constexpr size_t W_SSP3 = W_SSP2 + 1179648;
constexpr size_t W_END = W_SSP3 + 1179648;
constexpr size_t W_MLKV = W_WIN;
constexpr size_t W_MLCS = W_WIN + 33554432;
constexpr size_t W_MLN = W_SSP3 + 1179648;
constexpr size_t W_MLNS = W_MLN + 262144;
constexpr size_t W_MLSC = W_MLNS + 262144;
constexpr size_t W_CTR = W_MLSC + 8192;
constexpr size_t W_BAR = W_CTR + 256;
constexpr size_t W_END2 = W_BAR + 16384;
constexpr int ITEM_STRIDE = 81920, IT_W = 0, IT_QE = 17408, IT_QK = 34816, IT_KDT = 44032, IT_UT = 62464, IT_GL = 80896, ITEM_COPY16 = 5057;

struct Params { const float* in[24]; float* out; unsigned char* ws; };

typedef __bf16 bf16x2_t __attribute__((ext_vector_type(2)));
typedef float f32x2_t __attribute__((ext_vector_type(2)));
__device__ __forceinline__ unsigned pk_bf16(float lo, float hi) { const f32x2_t v = {lo, hi}; const bf16x2_t r = __builtin_convertvector(v, bf16x2_t); return __builtin_bit_cast(unsigned, r); }
__device__ __forceinline__ float bf_lo(unsigned u) { return __uint_as_float(u << 16); }
__device__ __forceinline__ float bf_hi(unsigned u) { return __uint_as_float(u & 0xffff0000u); }
__device__ __forceinline__ float bf2f(bf16_t b) { return __uint_as_float(((unsigned)b) << 16); }
__device__ __forceinline__ bf16_t f2bf(float f) { return (bf16_t)(pk_bf16(f, 0.f) & 0xffffu); }
__device__ __forceinline__ float siluf(float x) { return x * __builtin_amdgcn_rcpf(1.f + __expf(-x)); }
__device__ __forceinline__ float sigm(float x) { return __builtin_amdgcn_rcpf(1.f + __expf(-x)); }
__device__ __forceinline__ float softplusf(float x) { return x > 20.f ? x : log1pf(__expf(x)); }
__device__ __forceinline__ float logsigm(float x) { return fminf(x, 0.f) - log1pf(__expf(-fabsf(x))); }
__device__ __forceinline__ u32x4 pack8(const f32x4 a, const f32x4 b) { u32x4 w; w.x = pk_bf16(a[0], a[1]); w.y = pk_bf16(a[2], a[3]); w.z = pk_bf16(b[0], b[1]); w.w = pk_bf16(b[2], b[3]); return w; }
__device__ __forceinline__ bf16x8 as_bf16x8(u32x4 w) { return __builtin_bit_cast(bf16x8, w); }
__device__ __forceinline__ int opaque_tid() { int t = threadIdx.x; asm volatile("" : "+v"(t)); return t; }
__device__ __forceinline__ float wave_sum(float v) {
#pragma unroll
    for (int d = 32; d >= 1; d >>= 1) v += __shfl_xor(v, d);
    return v;
}
__device__ __forceinline__ const float* xrow(const Params& p, int row) { return row < NPT ? p.in[0] + (size_t)row * DM : p.in[1] + (size_t)(row - NPT) * DM; }

namespace pg8 {
constexpr int BM = 256, BK = 64, HALF = 128, HTB = HALF * BK * 2, STAGE_BYTES = 8 * HTB, NXCD = 8, WGM = 8;
__device__ __forceinline__ int lds_byte(int r, int c) { const int st = (r >> 4) * 2 + (c >> 5), rr = r & 15, cc = c & 31, ob = rr * 64 + cc * 2; return st * 1024 + (ob ^ (((ob >> 9) & 1) << 5)); }
__device__ __forceinline__ void stage_rc(int b, int& R, int& C) { const int st = b / 1024, sb = b % 1024, swz = sb ^ (((sb >> 9) & 1) << 5); R = (st >> 1) * 16 + swz / 64; C = (st & 1) * 32 + (swz % 64) / 2; }
__device__ __forceinline__ int perm32(int rho) { const int n = rho >> 4, i = rho & 15; return 8 * (i >> 2) + 4 * n + (i & 3); }
struct Unit { int pm, pn, ks; };
struct Gemm { const bf16_t* A; const bf16_t* Bt; int M, N, K, ld, nsplit; };
struct StaticOrder {
    int nM, nN, nwg, G, c;
    __device__ void init(int M, int N, int G_, int c_) { nM = M / BM; nN = N / BM; nwg = nM * nN; G = G_; c = c_; }
    __device__ bool next(int i, Unit& u) const {
        const long L = (long)i * G + c; if (L >= nwg) return false;
        int wgid = (int)L; { const int q = nwg / NXCD, r = nwg % NXCD, xcd = wgid % NXCD, off = wgid / NXCD; wgid = (xcd < r ? xcd * (q + 1) : r * (q + 1) + (xcd - r) * q) + off; }
        const int nig = WGM * nN, gid = wgid / nig, fm = gid * WGM, gsz = (nM - fm) < WGM ? (nM - fm) : WGM;
        u.pm = fm + ((wgid % nig) % gsz); u.pn = (wgid % nig) / gsz; u.ks = 0; return true;
    }
};
struct OneUnit { int pm, pn; __device__ bool next(int i, Unit& u) const { u.pm = pm; u.pn = pn; u.ks = 0; return i == 0; } };
template <class Epi, class Sched>
__device__ __forceinline__ void gemm_phase(LAS unsigned char* lds, const Gemm g, const Sched& S, const Epi& E) {
    const int tid = opaque_tid(), wid = __builtin_amdgcn_readfirstlane(tid >> 6), lane = tid & 63, wr = wid >> 2, wc = wid & 3, fr = lane & 15, fq = lane >> 4;
    const int K = g.K, nt = K / BK;
    unsigned voffA[2], voffB[2];
#pragma unroll
    for (int i = 0; i < 2; ++i) { int R, C; stage_rc(tid * 16 + i * 8192, R, C); const int Rb = (R & ~31) + perm32(R & 31);
        voffA[i] = (unsigned)(R * g.ld + C) * 2u; voffB[i] = (unsigned)(Rb * g.ld + C) * 2u; }
    const size_t kstep = (size_t)(BK * 2);
    const size_t hstep = (size_t)HALF * g.ld * 2;
    const size_t tstep = 2 * hstep;
    const unsigned ldsw = (unsigned)wid * 1024u;
    const int aoff = lds_byte(wr * 64 + fr, fq * 8), boff = lds_byte(wc * 32 + fr, fq * 8);
#define PG8_SA(b, h) (((b) * 2 + (h)) * HTB)
#define PG8_SB(b, h) ((4 + (b) * 2 + (h)) * HTB)
#define PG8_STAGE(bufoff, gbase, voff) do { _Pragma("unroll") for (int _i = 0; _i < 2; ++_i) \
        __builtin_amdgcn_global_load_lds((const unsigned*)((const char*)(gbase) + (voff)[_i]), (LAS unsigned*)(lds + (bufoff) + ldsw + _i * 8192), 16, 0, 0); } while (0)
#define PG8_LDA(dst, b, h) do { _Pragma("unroll") for (int m = 0; m < 4; ++m) _Pragma("unroll") for (int k = 0; k < 2; ++k) dst[m][k] = *(const LAS bf16x8*)(lds + PG8_SA(b, h) + aoff + m * 2048 + k * 1024); } while (0)
#define PG8_LDB(dst, b, h) do { _Pragma("unroll") for (int n = 0; n < 2; ++n) _Pragma("unroll") for (int k = 0; k < 2; ++k) dst[n][k] = *(const LAS bf16x8*)(lds + PG8_SB(b, h) + boff + n * 2048 + k * 1024); } while (0)
#define PG8_MMA(ai, bj, At, Bt) do { __builtin_amdgcn_s_setprio(1); _Pragma("unroll") for (int m = 0; m < 4; ++m) _Pragma("unroll") for (int n = 0; n < 2; ++n) _Pragma("unroll") for (int k = 0; k < 2; ++k) \
        acc[ai][bj][m][n] = __builtin_amdgcn_mfma_f32_16x16x32_bf16(Bt[n][k], At[m][k], acc[ai][bj][m][n], 0, 0, 0); __builtin_amdgcn_s_setprio(0); } while (0)
#define PG8_WAIT_V(n) asm volatile("s_waitcnt vmcnt(" #n ")" ::: "memory")
#define PG8_WAIT_L(n) asm volatile("s_waitcnt lgkmcnt(" #n ")" ::: "memory")
#define PG8_BAR __builtin_amdgcn_s_barrier()
#define PG8_SCHED __builtin_amdgcn_sched_barrier(0)
    Unit cur, nxt; int ui = 0;
    if (!S.next(0, cur)) return;
    const int nsp = g.nsplit; const size_t ksb = (size_t)K * 2;
    cur.ks = cur.pn % nsp; cur.pn /= nsp;
    f32x4 acc[2][2][4][2];
#pragma unroll
    for (int a = 0; a < 2; ++a)
#pragma unroll
        for (int b = 0; b < 2; ++b)
#pragma unroll
            for (int m = 0; m < 4; ++m)
#pragma unroll
                for (int n = 0; n < 2; ++n) acc[a][b][m][n] = (f32x4){0.f, 0.f, 0.f, 0.f};
    bf16x8 At[4][2], B0[2][2], B1[2][2];
    const char* cA = (const char*)g.A + (size_t)cur.pm * tstep + cur.ks * ksb; const char* cB = (const char*)g.Bt + (size_t)cur.pn * tstep + cur.ks * ksb;
    PG8_STAGE(PG8_SB(0, 0), cB, voffB); PG8_STAGE(PG8_SA(0, 0), cA, voffA); PG8_STAGE(PG8_SB(0, 1), cB + hstep, voffB); PG8_STAGE(PG8_SA(0, 1), cA + hstep, voffA);
    if (wr == 1) PG8_BAR;
    PG8_WAIT_V(4); PG8_BAR;
    PG8_STAGE(PG8_SB(1, 0), cB + kstep, voffB); PG8_STAGE(PG8_SA(1, 0), cA + kstep, voffA); PG8_STAGE(PG8_SB(1, 1), cB + hstep + kstep, voffB);
    PG8_WAIT_V(6); PG8_BAR;
    for (;;) {
        const bool has_next = S.next(ui + 1, nxt);
        if (has_next) { nxt.ks = nxt.pn % nsp; nxt.pn /= nsp; }
        const char* nA = has_next ? (const char*)g.A + (size_t)nxt.pm * tstep + nxt.ks * ksb : cA; const char* nB = has_next ? (const char*)g.Bt + (size_t)nxt.pn * tstep + nxt.ks * ksb : cB;
        for (int t = 0; t < nt; t += 2) {
            const bool last = (t == nt - 2);
            const char* a1 = cA + (size_t)(t + 1) * kstep;
            const char* a2 = last ? nA : cA + (size_t)(t + 2) * kstep; const char* b2 = last ? nB : cB + (size_t)(t + 2) * kstep;
            const char* a3 = a2 + kstep; const char* b3 = b2 + kstep;
            PG8_LDB(B0, 0, 0); PG8_SCHED; PG8_LDA(At, 0, 0); PG8_STAGE(PG8_SA(1, 1), a1 + hstep, voffA);
            PG8_WAIT_L(8); PG8_BAR; PG8_WAIT_L(0); PG8_MMA(0, 0, At, B0); PG8_BAR; PG8_SCHED;
            PG8_LDB(B1, 0, 1); PG8_STAGE(PG8_SB(0, 0), b2, voffB);
            PG8_BAR; PG8_WAIT_L(0); PG8_MMA(0, 1, At, B1); PG8_BAR;
            PG8_LDA(At, 0, 1); PG8_STAGE(PG8_SA(0, 0), a2, voffA);
            PG8_BAR; PG8_WAIT_L(0); PG8_MMA(1, 0, At, B0); PG8_BAR; PG8_SCHED;
            PG8_STAGE(PG8_SB(0, 1), b2 + hstep, voffB);
            PG8_WAIT_V(6); PG8_BAR; PG8_MMA(1, 1, At, B1); PG8_BAR;
            PG8_LDB(B0, 1, 0); PG8_SCHED; PG8_LDA(At, 1, 0); PG8_STAGE(PG8_SA(0, 1), a2 + hstep, voffA);
            PG8_WAIT_L(8); PG8_BAR; PG8_WAIT_L(0); PG8_MMA(0, 0, At, B0); PG8_BAR; PG8_SCHED;
            PG8_LDB(B1, 1, 1); PG8_STAGE(PG8_SB(1, 0), b3, voffB);
            PG8_BAR; PG8_WAIT_L(0); PG8_MMA(0, 1, At, B1); PG8_BAR;
            PG8_LDA(At, 1, 1); PG8_STAGE(PG8_SA(1, 0), a3, voffA);
            PG8_BAR; PG8_WAIT_L(0); PG8_MMA(1, 0, At, B0); PG8_BAR; PG8_SCHED;
            PG8_STAGE(PG8_SB(1, 1), b3 + hstep, voffB);
            PG8_WAIT_V(6); PG8_BAR; PG8_MMA(1, 1, At, B1); PG8_BAR;
        }
        E(acc, cur, wr, wc, fr, fq);
        if (!has_next) break;
#pragma unroll
        for (int a = 0; a < 2; ++a)
#pragma unroll
            for (int b = 0; b < 2; ++b)
#pragma unroll
                for (int m = 0; m < 4; ++m)
#pragma unroll
                    for (int n = 0; n < 2; ++n) acc[a][b][m][n] = (f32x4){0.f, 0.f, 0.f, 0.f};
        cur = nxt; cA = nA; cB = nB; ++ui;
    }
    PG8_WAIT_V(0);
    if (wr == 0) PG8_BAR;
    PG8_BAR;
#undef PG8_SA
#undef PG8_SB
#undef PG8_STAGE
#undef PG8_LDA
#undef PG8_LDB
#undef PG8_MMA
#undef PG8_WAIT_V
#undef PG8_WAIT_L
#undef PG8_BAR
#undef PG8_SCHED
}
}

template <bool SSP> struct EpiScaleBf16 {
    bf16_t* O; int ldc; const float* rs;
    __device__ __forceinline__ void operator()(const f32x4 (&acc)[2][2][4][2], const pg8::Unit& u, int wr, int wc, int fr, int fq) const {
        const int row0 = u.pm * 256 + wr * 64 + fr, col0 = u.pn * 256 + wc * 32 + 8 * fq;
#pragma unroll
        for (int ai = 0; ai < 2; ++ai)
#pragma unroll
            for (int m = 0; m < 4; ++m) {
                const int row = row0 + ai * 128 + m * 16;
                float s;
                if (SSP) { const f32x4* q = (const f32x4*)(rs + (size_t)row * 32) + 2 * fq;
                    const f32x4 t = q[0] + q[1];
                    float ts = t[0] + t[1] + t[2] + t[3];
                    ts += __shfl_xor(ts, 16); ts += __shfl_xor(ts, 32);
                    s = rsqrtf(ts * (1.f / 2048.f) + EPS); }
                else s = rs[row];
                bf16_t* rowp = O + (size_t)row * ldc + col0;
#pragma unroll
                for (int bj = 0; bj < 2; ++bj) *(u32x4*)(rowp + bj * 128) = pack8(acc[ai][bj][m][0] * s, acc[ai][bj][m][1] * s);
            }
    }
};
struct EpiResid {
    const float* resP; const float* resS; float* Y; bf16_t* Xb; float* ssp; float* P1;
    __device__ __forceinline__ void operator()(const f32x4 (&acc)[2][2][4][2], const pg8::Unit& u, int wr, int wc, int fr, int fq) const {
        const int row0 = u.pm * 256 + wr * 64 + fr, col0 = u.pn * 256 + wc * 32 + 8 * fq;
        if (u.ks != 0) {
#pragma unroll
            for (int ai = 0; ai < 2; ++ai)
#pragma unroll
                for (int m = 0; m < 4; ++m) {
                    float* yp = P1 + (size_t)(row0 + ai * 128 + m * 16) * DM + col0;
#pragma unroll
                    for (int bj = 0; bj < 2; ++bj) { *(f32x4*)(yp + bj * 128) = acc[ai][bj][m][0]; *(f32x4*)(yp + bj * 128 + 4) = acc[ai][bj][m][1]; }
                }
            return;
        }
#pragma unroll
        for (int ai = 0; ai < 2; ++ai) {
            f32x4 r[4][2][2];
#pragma unroll
            for (int m = 0; m < 4; ++m) {
                const int row = row0 + ai * 128 + m * 16;
                const float* res = (row < NPT ? resP + (size_t)row * DM : resS + (size_t)(row - NPT) * DM) + col0;
#pragma unroll
                for (int bj = 0; bj < 2; ++bj) { r[m][bj][0] = *(const f32x4*)(res + bj * 128); r[m][bj][1] = *(const f32x4*)(res + bj * 128 + 4); }
            }
            __builtin_amdgcn_sched_barrier(0);
#pragma unroll
            for (int m = 0; m < 4; ++m) {
                const int row = row0 + ai * 128 + m * 16;
                float* yp = Y + (size_t)row * DM + col0;
                float ss = 0.f;
#pragma unroll
                for (int bj = 0; bj < 2; ++bj) {
                    const f32x4 v0 = acc[ai][bj][m][0] + r[m][bj][0], v1 = acc[ai][bj][m][1] + r[m][bj][1];
                    *(f32x4*)(yp + bj * 128) = v0; *(f32x4*)(yp + bj * 128 + 4) = v1;
                    if (Xb) *(u32x4*)(Xb + (size_t)row * DM + col0 + bj * 128) = pack8(v0, v1);
                    ss += v0[0] * v0[0] + v0[1] * v0[1] + v0[2] * v0[2] + v0[3] * v0[3] + v1[0] * v1[0] + v1[1] * v1[1] + v1[2] * v1[2] + v1[3] * v1[3];
                }
                if (ssp) {
                    ss += __shfl_xor(ss, 16); ss += __shfl_xor(ss, 32);
                    if (fq == 0) ssp[(size_t)row * 32 + u.pn * 4 + wc] = ss;
                }
            }
        }
    }
};

__device__ __forceinline__ void conv_tile(const float* __restrict__ W, int N, int src, const float* __restrict__ gk, bf16_t* __restrict__ dst, int k0) {
    float v[64];
#pragma unroll
    for (int j = 0; j < 64; ++j) v[j] = __builtin_nontemporal_load(W + (size_t)(k0 + j) * N + src);
    if (gk) {
#pragma unroll
        for (int j = 0; j < 64; ++j) v[j] *= gk[k0 + j];
    }
#pragma unroll
    for (int kb = 0; kb < 64; kb += 8) {
        u32x4 a;
        a.x = pk_bf16(v[kb], v[kb + 1]); a.y = pk_bf16(v[kb + 2], v[kb + 3]); a.z = pk_bf16(v[kb + 4], v[kb + 5]); a.w = pk_bf16(v[kb + 6], v[kb + 7]);
        *(u32x4*)(dst + kb) = a;
    }
}

__device__ __forceinline__ void phase0(const Params& p, LAS unsigned char* lds) {
    const int tid = opaque_tid(), wave = tid >> 6, lane = tid & 63, fr = lane & 15, fq = lane >> 4;
    const int G = gridDim.x, GW = G * 8, gw = wave * G + blockIdx.x;
    const float* w_in = p.in[9]; const float* g1 = p.in[8];
    unsigned char* ws = p.ws;
    constexpr int WGS = 4112;
    {
        const int n = tid & 31, kb = tid >> 5;
        const int col = n < 16 ? 4096 + n : 7184 + (n - 16);
#pragma unroll 1
        for (int k0 = 0; k0 < 2048; k0 += 512) {
            float v[32], gg[32];
#pragma unroll
            for (int i = 0; i < 32; ++i) { const int k = k0 + 16 * i + kb; v[i] = n < 24 ? w_in[(size_t)k * PROJ_COLS + col] : 0.f; gg[i] = g1[k]; }
#pragma unroll
            for (int i = 0; i < 32; ++i) { const int k = k0 + 16 * i + kb; *(LAS bf16_t*)(lds + n * WGS + k * 2) = f2bf(v[i] * gg[i]); }
        }
    }
    if (blockIdx.x == 0 && tid == 0) { unsigned* c_ = (unsigned*)(ws + W_CTR); c_[0] = 0u; c_[32] = 0u; c_[48] = 0u; }
    __syncthreads();
    bf16_t* xb = (bf16_t*)(ws + W_XB); float* rstd1 = (float*)(ws + W_RSTD1); float* gates = (float*)(ws + W_GATES);
    for (int t = gw; t < 576; t += GW) {
        const int R0 = t * 16, row = R0 + fr;
        const float* xr = xrow(p, row);
        f32x4 acc0 = {0.f, 0.f, 0.f, 0.f}, acc1 = {0.f, 0.f, 0.f, 0.f}; float ss = 0.f;
#pragma unroll 2
        for (int kb = 0; kb < 64; kb += 8) {
            f32x4 xa[8], xb4[8];
#pragma unroll
            for (int i = 0; i < 8; ++i) { xa[i] = __builtin_nontemporal_load((const f32x4*)(xr + (kb + i) * 32 + fq * 8)); xb4[i] = __builtin_nontemporal_load((const f32x4*)(xr + (kb + i) * 32 + fq * 8 + 4)); }
#pragma unroll
            for (int i = 0; i < 8; ++i) {
                const int kk = kb + i; const f32x4 a = xa[i], b = xb4[i];
                ss += a[0] * a[0] + a[1] * a[1] + a[2] * a[2] + a[3] * a[3] + b[0] * b[0] + b[1] * b[1] + b[2] * b[2] + b[3] * b[3];
                const u32x4 A = pack8(a, b);
                *(u32x4*)(xb + (size_t)row * DM + kk * 32 + fq * 8) = A;
                const bf16x8 B0 = *(const LAS bf16x8*)(lds + fr * WGS + (kk * 32 + fq * 8) * 2);
                const bf16x8 B1 = *(const LAS bf16x8*)(lds + (16 + fr) * WGS + (kk * 32 + fq * 8) * 2);
                acc0 = __builtin_amdgcn_mfma_f32_16x16x32_bf16(as_bf16x8(A), B0, acc0, 0, 0, 0);
                acc1 = __builtin_amdgcn_mfma_f32_16x16x32_bf16(as_bf16x8(A), B1, acc1, 0, 0, 0);
            }
        }
        ss += __shfl_xor(ss, 16); ss += __shfl_xor(ss, 32);
        const float rs = rsqrtf(ss * (1.f / 2048.f) + EPS);
        if (fq == 0) rstd1[row] = rs;
#pragma unroll
        for (int j = 0; j < 4; ++j) {
            const int m = fq * 4 + j; const float rm = __shfl(rs, m);
            gates[(size_t)(R0 + m) * 32 + fr] = acc0[j] * rm;
            if (fr < 8) gates[(size_t)(R0 + m) * 32 + 16 + fr] = acc1[j] * rm;
        }
    }
    if (gw >= 576 || GW <= 576) {
        const int cw = GW > 576 ? gw - 576 : gw, CW = GW > 576 ? GW - 576 : GW;
        for (int t = cw; t < 4608; t += CW) {
            if (t < 3584) { const int kt = t & 31, ntile = t >> 5, n = ntile * 64 + lane, src = n < 4096 ? n : n + 16;
                conv_tile(w_in, PROJ_COLS, src, g1, (bf16_t*)(ws + W_WIN) + (size_t)n * 2048 + kt * 64, kt * 64); }
            else { const int tt = t - 3584, kt = tt & 31, n = (tt >> 5) * 64 + lane;
                conv_tile(p.in[17], 2048, n, nullptr, (bf16_t*)(ws + W_WOUT) + (size_t)n * 2048 + kt * 64, kt * 64); }
        }
    }
}
__device__ __forceinline__ void convert_task(const Params& p, int t, int lane) {
    unsigned char* ws = p.ws;
    if (t < 5632) { const int kt = t & 31, n = (t >> 5) * 64 + lane;
        conv_tile(p.in[19], FF2, n, p.in[18], (bf16_t*)(ws + W_WUP) + (size_t)n * 2048 + kt * 64, kt * 64); }
    else { const int tt = t - 5632, kt = tt % 88, n = (tt / 88) * 64 + lane;
        conv_tile(p.in[22], 2048, n, nullptr, (bf16_t*)(ws + W_WDOWN) + (size_t)n * FF + kt * 64, kt * 64); }
}
__device__ __forceinline__ void convert_late(const Params& p) {
    const int lane = opaque_tid() & 63;
    unsigned* ctr = (unsigned*)(p.ws + W_CTR);
    for (;;) {
        unsigned tu = 0;
        if (lane == 0) tu = atomicAdd(ctr, 1u);
        const int t = __builtin_amdgcn_readfirstlane((int)tu);
        if (t >= 8448) break;
        convert_task(p, t, lane);
    }
}
__device__ __forceinline__ void convert_one(const Params& p, int lane) {
    unsigned* ctr = (unsigned*)(p.ws + W_CTR);
    unsigned tu = 0;
    if (lane == 0) tu = atomicAdd(ctr, 1u);
    const int t = __builtin_amdgcn_readfirstlane((int)tu);
    if (t < 8448) convert_task(p, t, lane);
}
__device__ __forceinline__ void signal_done(unsigned* c) {
    asm volatile("s_waitcnt vmcnt(0)" ::: "memory");
    __syncthreads();
    if (threadIdx.x == 0) {
        __builtin_amdgcn_fence(__ATOMIC_RELEASE, "agent");
        asm volatile("s_waitcnt vmcnt(0)" ::: "memory");
        (void)__hip_atomic_fetch_add(c, 1u, __ATOMIC_RELAXED, __HIP_MEMORY_SCOPE_AGENT);
    }
}
__device__ __forceinline__ void wait_count(unsigned* c, unsigned need) {
    if (threadIdx.x == 0) {
        unsigned sp = 0u;
        while (__hip_atomic_load(c, __ATOMIC_RELAXED, __HIP_MEMORY_SCOPE_AGENT) < need) { __builtin_amdgcn_s_sleep(2); if (++sp > (1u << 20)) break; }
        __builtin_amdgcn_fence(__ATOMIC_ACQUIRE, "agent");
        asm volatile("s_waitcnt vmcnt(0)" ::: "memory");
    }
    __syncthreads();
}

__device__ __forceinline__ void phase2(const Params& p, LAS unsigned char* lds) {
    const int tid = opaque_tid(), wave = tid >> 6, lane = tid & 63, fr = lane & 15, fq = lane >> 4;
    unsigned char* ws = p.ws;
    const bf16_t* proj = (const bf16_t*)(ws + W_PROJ); const float* gates = (const float*)(ws + W_GATES);
    const float* convw = p.in[10];
    constexpr int L_Q = 0, L_K = 33792, L_V = 67584, L_QN = 101376, L_KN = 118784, L_SM = 136192, L_A = 0;
    LAS float* s_beta = (LAS float*)(lds + L_SM); LAS float* s_G = s_beta + 64; LAS float* s_eG = s_beta + 128; LAS float* s_ekd = s_beta + 192;
    for (int item = blockIdx.x; item < 1024; item += gridDim.x) {
        const int n = item & 31, h = (item >> 5) & 7, b = item >> 8;
        const int tok0 = b * SEQL + n * 64;
        unsigned char* ib = ws + W_ITEMS + (size_t)item * ITEM_STRIDE;
        if (tid < 384) {
            const int cgp = tid % 48, rr = tid / 48, sec = cgp >> 4, d0 = (cgp & 15) * 8, ch = sec * 1024 + h * 128 + d0;
            float w[4][8];
#pragma unroll
            for (int j = 0; j < 4; ++j) { const f32x4 a = *(const f32x4*)(convw + j * 3072 + ch), c = *(const f32x4*)(convw + j * 3072 + ch + 4);
                w[j][0] = a[0]; w[j][1] = a[1]; w[j][2] = a[2]; w[j][3] = a[3]; w[j][4] = c[0]; w[j][5] = c[1]; w[j][6] = c[2]; w[j][7] = c[3]; }
            u32x4 xw[11];
#pragma unroll
            for (int i = 0; i < 11; ++i) { const int t = n * 64 + rr * 8 - 3 + i;
                xw[i] = t >= 0 ? *(const u32x4*)(proj + (size_t)(tok0 + rr * 8 - 3 + i) * PCOL + ch) : (u32x4){0u, 0u, 0u, 0u}; }
            LAS float* dst = (LAS float*)(lds + (sec == 0 ? L_Q : sec == 1 ? L_K : L_V));
#pragma unroll
            for (int i = 0; i < 8; ++i) {
                float o[8];
#pragma unroll
                for (int e = 0; e < 8; ++e) o[e] = 0.f;
#pragma unroll
                for (int j = 0; j < 4; ++j) { const u32x4 x = xw[i + j];
                    o[0] += w[j][0] * bf_lo(x.x); o[1] += w[j][1] * bf_hi(x.x); o[2] += w[j][2] * bf_lo(x.y); o[3] += w[j][3] * bf_hi(x.y);
                    o[4] += w[j][4] * bf_lo(x.z); o[5] += w[j][5] * bf_hi(x.z); o[6] += w[j][6] * bf_lo(x.w); o[7] += w[j][7] * bf_hi(x.w); }
                LAS float* d = dst + (rr * 8 + i) * 132 + d0;
                *(LAS f32x4*)d = (f32x4){siluf(o[0]), siluf(o[1]), siluf(o[2]), siluf(o[3])};
                *(LAS f32x4*)(d + 4) = (f32x4){siluf(o[4]), siluf(o[5]), siluf(o[6]), siluf(o[7])};
            }
        }
        if (wave == 7) {
            const int row = tok0 + lane;
            const float be = sigm(gates[(size_t)row * 32 + h]);
            const float g = -__expf(p.in[11][h]) * softplusf(gates[(size_t)row * 32 + 8 + h] + p.in[12][h]);
            float Gc = g;
#pragma unroll
            for (int d = 1; d < 64; d <<= 1) { const float t = __shfl_up(Gc, d); if (lane >= d) Gc += t; }
            const float Gl = __shfl(Gc, 63);
            s_beta[lane] = be; s_G[lane] = Gc; s_eG[lane] = __expf(Gc); s_ekd[lane] = __expf(Gl - Gc);
            if (lane == 0) *(float*)(ib + IT_GL) = __expf(Gl);
        }
        __syncthreads();
        {
            const int row = tid >> 2, part = tid & 3, isk = row >> 6, r = row & 63;
            const LAS float* src = (const LAS float*)(lds + (isk ? L_K : L_Q)) + r * 132 + part * 32;
            f32x4 v[8]; float ss = 0.f;
#pragma unroll
            for (int i = 0; i < 8; ++i) { v[i] = *(const LAS f32x4*)(src + i * 4); ss += v[i][0] * v[i][0] + v[i][1] * v[i][1] + v[i][2] * v[i][2] + v[i][3] * v[i][3]; }
            ss += __shfl_xor(ss, 1); ss += __shfl_xor(ss, 2);
            const float rn = rsqrtf(ss + EPS) * (isk ? 1.f : 0.08838834764831845f);
            LAS unsigned char* dst = lds + (isk ? L_KN : L_QN) + r * 272 + part * 64;
#pragma unroll
            for (int i = 0; i < 4; ++i) *(LAS u32x4*)(dst + i * 16) = pack8(v[2 * i] * rn, v[2 * i + 1] * rn);
        }
        __syncthreads();
        {
#pragma unroll
            for (int q = 0; q < 4; ++q) {
                const int tt = wave * 4 + q, which = tt >> 4, it = (tt & 15) >> 2, jt = tt & 3;
                f32x4 acc = {0.f, 0.f, 0.f, 0.f};
                const LAS unsigned char* ap = lds + (which ? L_QN : L_KN) + (16 * it + fr) * 272 + fq * 16;
                const LAS unsigned char* bp = lds + L_KN + (16 * jt + fr) * 272 + fq * 16;
#pragma unroll
                for (int kk = 0; kk < 4; ++kk) acc = __builtin_amdgcn_mfma_f32_16x16x32_bf16(*(const LAS bf16x8*)(ap + kk * 64), *(const LAS bf16x8*)(bp + kk * 64), acc, 0, 0, 0);
                const int j = 16 * jt + fr; const float Gj = s_G[j];
#pragma unroll
                for (int e = 0; e < 4; ++e) {
                    const int i = 16 * it + 4 * fq + e;
                    const float dec = __expf(fminf(s_G[i] - Gj, 0.f));
                    if (which == 0) ((LAS float*)(lds + L_A))[j * 68 + i] = (i > j) ? acc[e] * s_beta[i] * dec : 0.f;
                    else *(bf16_t*)(ib + IT_QK + i * 144 + j * 2) = f2bf((i >= j) ? acc[e] * dec : 0.f);
                }
            }
        }
        __syncthreads();
        if (tid < 256) {
            const LAS float* At = (const LAS float*)(lds + L_A);
            const bool isu = tid < 128; const int col = isu ? tid : tid - 128;
            LAS float* X = (LAS float*)(lds + (isu ? L_V : L_K)) + col;
#pragma unroll 1
            for (int blk = 0; blk < 4; ++blk) {
                float acc[16];
#pragma unroll
                for (int ii = 0; ii < 16; ++ii) { const int i = 16 * blk + ii;
                    acc[ii] = isu ? X[i * 132] * s_beta[i] : bf2f(*(const LAS bf16_t*)(lds + L_KN + i * 272 + col * 2)) * s_beta[i] * s_eG[i]; }
#pragma unroll 4
                for (int j = 0; j < 16 * blk; ++j) {
                    const float xj = X[j * 132];
                    const LAS float* ar = At + j * 68 + 16 * blk;
                    const f32x4 a0 = *(const LAS f32x4*)ar, a1 = *(const LAS f32x4*)(ar + 4), a2 = *(const LAS f32x4*)(ar + 8), a3 = *(const LAS f32x4*)(ar + 12);
#pragma unroll
                    for (int e = 0; e < 4; ++e) { acc[e] -= a0[e] * xj; acc[4 + e] -= a1[e] * xj; acc[8 + e] -= a2[e] * xj; acc[12 + e] -= a3[e] * xj; }
                }
#pragma unroll
                for (int jj = 0; jj < 15; ++jj) {
                    const float xj = acc[jj];
                    const LAS float* ar = At + (16 * blk + jj) * 68 + 16 * blk;
                    const f32x4 a0 = *(const LAS f32x4*)ar, a1 = *(const LAS f32x4*)(ar + 4), a2 = *(const LAS f32x4*)(ar + 8), a3 = *(const LAS f32x4*)(ar + 12);
                    const float av[16] = {a0[0], a0[1], a0[2], a0[3], a1[0], a1[1], a1[2], a1[3], a2[0], a2[1], a2[2], a2[3], a3[0], a3[1], a3[2], a3[3]};
#pragma unroll
                    for (int ii = jj + 1; ii < 16; ++ii) acc[ii] -= av[ii] * xj;
                }
#pragma unroll
                for (int ii = 0; ii < 16; ++ii) X[(16 * blk + ii) * 132] = acc[ii];
            }
            if (isu) {
#pragma unroll 1
                for (int i = 0; i < 8; ++i) { u32x4 w; w.x = pk_bf16(X[(8 * i) * 132], X[(8 * i + 1) * 132]); w.y = pk_bf16(X[(8 * i + 2) * 132], X[(8 * i + 3) * 132]);
                    w.z = pk_bf16(X[(8 * i + 4) * 132], X[(8 * i + 5) * 132]); w.w = pk_bf16(X[(8 * i + 6) * 132], X[(8 * i + 7) * 132]);
                    *(u32x4*)(ib + IT_UT + col * 144 + i * 16) = w; }
            } else {
#pragma unroll 4
                for (int i = 0; i < 64; ++i) *(bf16_t*)(ib + IT_W + i * 272 + col * 2) = f2bf(X[i * 132]);
            }
        } else {
            const int t2 = tid - 256;
            { const int i = t2 >> 2, part = t2 & 3; const float sc = s_eG[i];
#pragma unroll
              for (int q = 0; q < 4; ++q) { const u32x4 v = *(const LAS u32x4*)(lds + L_QN + i * 272 + part * 64 + q * 16); u32x4 w;
                  w.x = pk_bf16(bf_lo(v.x) * sc, bf_hi(v.x) * sc); w.y = pk_bf16(bf_lo(v.y) * sc, bf_hi(v.y) * sc); w.z = pk_bf16(bf_lo(v.z) * sc, bf_hi(v.z) * sc); w.w = pk_bf16(bf_lo(v.w) * sc, bf_hi(v.w) * sc);
                  *(u32x4*)(ib + IT_QE + i * 272 + part * 64 + q * 16) = w; } }
            { const int k = t2 & 127, cg2 = t2 >> 7;
#pragma unroll
              for (int q = 0; q < 4; ++q) { float v[8];
#pragma unroll
                  for (int e = 0; e < 8; ++e) { const int c = cg2 * 32 + q * 8 + e; v[e] = bf2f(*(const LAS bf16_t*)(lds + L_KN + c * 272 + k * 2)) * s_ekd[c]; }
                  u32x4 w; w.x = pk_bf16(v[0], v[1]); w.y = pk_bf16(v[2], v[3]); w.z = pk_bf16(v[4], v[5]); w.w = pk_bf16(v[6], v[7]);
                  *(u32x4*)(ib + IT_KDT + k * 144 + cg2 * 64 + q * 16) = w; } }
            convert_one(p, lane);
        }
        __syncthreads();
    }
    {
        float* out = p.out;
        const int gt = blockIdx.x * 512 + tid, GT = gridDim.x * 512;
        for (int i = gt; i < 128 * 3 * 3072; i += GT) { const int c = i % 3072, j = (i / 3072) % 3, s = i / 9216;
            out[O_S_DNCONV + i] = bf2f(proj[(size_t)(NPT + 8 * s + 5 + j) * PCOL + c]); }
        for (int i = gt; i < 4 * 3 * 3072; i += GT) { const int c = i % 3072, j = (i / 3072) % 3, b = i / 9216;
            out[O_P_DNCONV + i] = bf2f(proj[(size_t)(b * SEQL + 2045 + j) * PCOL + c]); }
    }
}

__device__ __forceinline__ bf16x8 frag2(const LAS unsigned char* p) {
    const u32x2 a = *(const LAS u32x2*)p, b = *(const LAS u32x2*)(p + 32); u32x4 w; w.x = a.x; w.y = a.y; w.z = b.x; w.w = b.y; return as_bf16x8(w);
}
#define MFMA16(A, B, C) __builtin_amdgcn_mfma_f32_16x16x32_bf16((A), (B), (C), 0, 0, 0)

__device__ __forceinline__ void scan_dn(const Params& p, LAS unsigned char* lds, int bh) {
    const int tid = opaque_tid(), wave = tid >> 6, lane = tid & 63, fr = lane & 15, fq = lane >> 4;
    const int b = bh >> 3, h = bh & 7;
    unsigned char* ws = p.ws;
    const bf16_t* proj = (const bf16_t*)(ws + W_PROJ); bf16_t* mix = (bf16_t*)(ws + W_MIX);
    const unsigned char* items = ws + W_ITEMS + (size_t)bh * 32 * ITEM_STRIDE;
    constexpr int L_O = 81920;
    f32x4 S[8];
#pragma unroll
    for (int i = 0; i < 8; ++i) S[i] = (f32x4){0.f, 0.f, 0.f, 0.f};
    u32x4 pf[10];
#pragma unroll
    for (int i = 0; i < 10; ++i) { const int idx = tid + 512 * i; if (idx < ITEM_COPY16) pf[i] = __builtin_nontemporal_load((const u32x4*)(items + (size_t)idx * 16)); }
    const bf16_t* zbase = proj + (size_t)(b * SEQL + (tid >> 3)) * PCOL + PC_DNZ + h * 128 + (tid & 7) * 16;
    u32x4 zc0 = *(const u32x4*)zbase, zc1 = *(const u32x4*)(zbase + 8), zn0 = zc0, zn1 = zc1;
    f32x4 gpv[4];
#pragma unroll
    for (int i = 0; i < 4; ++i) gpv[i] = *(const f32x4*)(p.in[13] + (tid & 7) * 16 + 4 * i);
    for (int n = 0; n < 32; ++n) {
#pragma unroll
        for (int i = 0; i < 10; ++i) { const int idx = tid + 512 * i; if (idx < ITEM_COPY16) *(LAS u32x4*)(lds + idx * 16) = pf[i]; }
        __syncthreads();
        if (n + 1 < 32) {
            const unsigned char* nx = items + (size_t)(n + 1) * ITEM_STRIDE;
#pragma unroll
            for (int i = 0; i < 10; ++i) { const int idx = tid + 512 * i; if (idx < ITEM_COPY16) pf[i] = __builtin_nontemporal_load((const u32x4*)(nx + (size_t)idx * 16)); }
            zn0 = *(const u32x4*)(zbase + (size_t)(n + 1) * 64 * PCOL); zn1 = *(const u32x4*)(zbase + (size_t)(n + 1) * 64 * PCOL + 8);
        }
        const float gl = *(const LAS float*)(lds + IT_GL);
        bf16x8 Bs[4];
#pragma unroll
        for (int kk = 0; kk < 4; ++kk) Bs[kk] = as_bf16x8(pack8(S[2 * kk], S[2 * kk + 1]));
        f32x4 T1[4], T2[4];
#pragma unroll
        for (int mt = 0; mt < 4; ++mt) {
            T1[mt] = (f32x4){0.f, 0.f, 0.f, 0.f}; T2[mt] = (f32x4){0.f, 0.f, 0.f, 0.f};
#pragma unroll
            for (int kk = 0; kk < 4; ++kk) {
                T1[mt] = MFMA16(frag2(lds + IT_W + (16 * mt + fr) * 272 + kk * 64 + fq * 8), Bs[kk], T1[mt]);
                T2[mt] = MFMA16(frag2(lds + IT_QE + (16 * mt + fr) * 272 + kk * 64 + fq * 8), Bs[kk], T2[mt]);
            }
        }
#pragma unroll
        for (int mt = 0; mt < 4; ++mt) {
            const u32x2 uu = *(const LAS u32x2*)(lds + IT_UT + (16 * wave + fr) * 144 + (16 * mt + 4 * fq) * 2);
            T1[mt] = (f32x4){bf_lo(uu.x) - T1[mt][0], bf_hi(uu.x) - T1[mt][1], bf_lo(uu.y) - T1[mt][2], bf_hi(uu.y) - T1[mt][3]};
        }
        bf16x8 Bv[2];
#pragma unroll
        for (int kc = 0; kc < 2; ++kc) Bv[kc] = as_bf16x8(pack8(T1[2 * kc], T1[2 * kc + 1]));
#pragma unroll
        for (int mt = 0; mt < 4; ++mt)
#pragma unroll
            for (int kc = 0; kc < 2; ++kc) T2[mt] = MFMA16(frag2(lds + IT_QK + (16 * mt + fr) * 144 + kc * 64 + fq * 8), Bv[kc], T2[mt]);
#pragma unroll
        for (int mk = 0; mk < 8; ++mk) {
            S[mk] *= gl;
#pragma unroll
            for (int kc = 0; kc < 2; ++kc) S[mk] = MFMA16(frag2(lds + IT_KDT + (16 * mk + fr) * 144 + kc * 64 + fq * 8), Bv[kc], S[mk]);
        }
#pragma unroll
        for (int mt = 0; mt < 4; ++mt)
#pragma unroll
            for (int e = 0; e < 4; ++e) ((LAS float*)(lds + L_O))[(16 * mt + 4 * fq + e) * 132 + 16 * wave + fr] = T2[mt][e];
        __syncthreads();
        {
            const int c = tid >> 3, part = tid & 7, row = b * SEQL + n * 64 + c;
            const LAS float* op = (const LAS float*)(lds + L_O) + c * 132 + part * 16;
            f32x4 v[4]; float ss = 0.f;
#pragma unroll
            for (int i = 0; i < 4; ++i) { v[i] = *(const LAS f32x4*)(op + 4 * i); ss += v[i][0] * v[i][0] + v[i][1] * v[i][1] + v[i][2] * v[i][2] + v[i][3] * v[i][3]; }
            ss += __shfl_xor(ss, 1); ss += __shfl_xor(ss, 2); ss += __shfl_xor(ss, 4);
            const float rn = rsqrtf(ss * (1.f / 128.f) + EPS);
            const u32x4 z0 = zc0, z1 = zc1;
            const float gp[16] = {gpv[0][0], gpv[0][1], gpv[0][2], gpv[0][3], gpv[1][0], gpv[1][1], gpv[1][2], gpv[1][3], gpv[2][0], gpv[2][1], gpv[2][2], gpv[2][3], gpv[3][0], gpv[3][1], gpv[3][2], gpv[3][3]};
            float zz[16] = {bf_lo(z0.x), bf_hi(z0.x), bf_lo(z0.y), bf_hi(z0.y), bf_lo(z0.z), bf_hi(z0.z), bf_lo(z0.w), bf_hi(z0.w),
                            bf_lo(z1.x), bf_hi(z1.x), bf_lo(z1.y), bf_hi(z1.y), bf_lo(z1.z), bf_hi(z1.z), bf_lo(z1.w), bf_hi(z1.w)};
            float o[16];
#pragma unroll
            for (int i = 0; i < 16; ++i) o[i] = v[i >> 2][i & 3] * rn * gp[i] * siluf(zz[i]);
            u32x4 w0, w1;
            w0.x = pk_bf16(o[0], o[1]); w0.y = pk_bf16(o[2], o[3]); w0.z = pk_bf16(o[4], o[5]); w0.w = pk_bf16(o[6], o[7]);
            w1.x = pk_bf16(o[8], o[9]); w1.y = pk_bf16(o[10], o[11]); w1.z = pk_bf16(o[12], o[13]); w1.w = pk_bf16(o[14], o[15]);
            bf16_t* mp = mix + (size_t)row * DM + h * 128 + part * 16;
            *(u32x4*)mp = w0; *(u32x4*)(mp + 8) = w1;
            zc0 = zn0; zc1 = zn1;
        }
    }
    int l2 = tid; asm volatile("" : "+v"(l2));
    float* so = p.out + O_P_DNS + (size_t)bh * 128 * 128 + (size_t)(4 * ((l2 & 63) >> 4)) * 128 + 16 * (l2 >> 6) + (l2 & 15);
#pragma unroll
    for (int mk = 0; mk < 8; ++mk)
#pragma unroll
        for (int e = 0; e < 4; ++e) so[(16 * mk + e) * 128] = S[mk][e];
}

struct MlGate { float bc, av, Mi, M63, b63; };
__device__ __forceinline__ MlGate ml_gates(const float* gates, int tok0, int lane, int h, float fb, float ib, float m_prev) {
    const float fg = logsigm(gates[(size_t)(tok0 + lane) * 32 + 20 + h] + fb), ig = gates[(size_t)(tok0 + lane) * 32 + 16 + h] + ib;
    float bc = fg;
#pragma unroll
    for (int d = 1; d < 64; d <<= 1) { const float t = __shfl_up(bc, d); if (lane >= d) bc += t; }
    const float av = ig - bc;
    float pm = av;
#pragma unroll
    for (int d = 1; d < 64; d <<= 1) { const float t = __shfl_up(pm, d); if (lane >= d) pm = fmaxf(pm, t); }
    MlGate g; g.bc = bc; g.av = av; g.Mi = fmaxf(m_prev, pm); g.M63 = __shfl(g.Mi, 63); g.b63 = __shfl(bc, 63);
    return g;
}

__device__ __forceinline__ void ml_passA(const Params& p, LAS unsigned char* lds, int item) {
    const int tid = opaque_tid(), wave = tid >> 6, lane = tid & 63, fr = lane & 15, fq = lane >> 4;
    const int n = item & 31, bh = item >> 5, h = bh & 3, b = bh >> 2, tok0 = b * SEQL + n * 64;
    unsigned char* ws = p.ws;
    const bf16_t* proj = (const bf16_t*)(ws + W_PROJ); const float* gates = (const float*)(ws + W_GATES);
    constexpr int L_KT = 0, L_VT = 18432, L_RED = 55296;
    LAS float* red = (LAS float*)(lds + L_RED);
    const float ib = p.in[14][h], fb = p.in[15][h];
    float m_prev;
    {
        float fl[4], il[4], lsum = 0.f;
#pragma unroll
        for (int e = 0; e < 4; ++e) { const int sidx = tid * 4 + e; float f = 0.f, iv = -3.0e38f;
            if (sidx < n * 64) { const size_t row = (size_t)(b * SEQL + sidx); f = logsigm(gates[row * 32 + 20 + h] + fb); iv = gates[row * 32 + 16 + h] + ib; }
            lsum += f; fl[e] = lsum; il[e] = iv; }
        float incl = lsum;
#pragma unroll
        for (int d = 1; d < 64; d <<= 1) { const float t = __shfl_up(incl, d); if (lane >= d) incl += t; }
        if (lane == 63) red[wave] = incl;
        __syncthreads();
        float woff = 0.f, ftot = 0.f;
#pragma unroll
        for (int w = 0; w < 8; ++w) { const float r = red[w]; ftot += r; if (w < wave) woff += r; }
        const float excl = woff + incl - lsum;
        float mx = -3.0e38f;
#pragma unroll
        for (int e = 0; e < 4; ++e) mx = fmaxf(mx, il[e] - (excl + fl[e]));
#pragma unroll
        for (int d = 32; d >= 1; d >>= 1) mx = fmaxf(mx, __shfl_xor(mx, d));
        if (lane == 0) red[8 + wave] = mx;
        __syncthreads();
        float gm = 0.f;
#pragma unroll
        for (int w = 0; w < 8; ++w) gm = fmaxf(gm, red[8 + w]);
        m_prev = ftot + gm;
    }
    const MlGate g = ml_gates(gates, tok0, lane, h, fb, ib, m_prev);
    const float wend = __expf(g.av - g.M63), cs = __expf(m_prev - g.M63);
    const int lr = tid >> 3, lp = tid & 7;
    {
        const bf16_t* rp = proj + (size_t)(tok0 + lr) * PCOL;
        const u32x4 pk0 = *(const u32x4*)(rp + PC_MLK + h * 128 + lp * 16), pk1 = *(const u32x4*)(rp + PC_MLK + h * 128 + lp * 16 + 8);
        u32x4 pv[4];
#pragma unroll
        for (int i = 0; i < 4; ++i) pv[i] = *(const u32x4*)(rp + PC_MLV + h * 256 + lp * 32 + i * 8);
        const float we = __shfl(wend, lr & 63);
        const unsigned kw[8] = {pk0.x, pk0.y, pk0.z, pk0.w, pk1.x, pk1.y, pk1.z, pk1.w};
#pragma unroll
        for (int e = 0; e < 8; ++e) {
            *(LAS bf16_t*)(lds + L_KT + (lp * 16 + 2 * e) * 144 + lr * 2) = f2bf(bf_lo(kw[e]) * we);
            *(LAS bf16_t*)(lds + L_KT + (lp * 16 + 2 * e + 1) * 144 + lr * 2) = f2bf(bf_hi(kw[e]) * we);
        }
#pragma unroll
        for (int i = 0; i < 4; ++i) { const unsigned vw[4] = {pv[i].x, pv[i].y, pv[i].z, pv[i].w};
#pragma unroll
            for (int e = 0; e < 4; ++e) {
                *(LAS bf16_t*)(lds + L_VT + (lp * 32 + i * 8 + 2 * e) * 144 + lr * 2) = (bf16_t)(vw[e] & 0xffffu);
                *(LAS bf16_t*)(lds + L_VT + (lp * 32 + i * 8 + 2 * e + 1) * 144 + lr * 2) = (bf16_t)(vw[e] >> 16);
            } }
    }
    __syncthreads();
    {
        bf16x8 Bv[2][2];
#pragma unroll
        for (int kc = 0; kc < 2; ++kc)
#pragma unroll
            for (int nt = 0; nt < 2; ++nt) Bv[kc][nt] = *(const LAS bf16x8*)(lds + L_VT + (32 * wave + 16 * nt + fr) * 144 + kc * 64 + fq * 16);
        unsigned char* kvb = (unsigned char*)p.out + (size_t)item * 65536;
#pragma unroll
        for (int mk = 0; mk < 8; ++mk) {
            f32x4 c0 = {0.f, 0.f, 0.f, 0.f}, c1 = {0.f, 0.f, 0.f, 0.f};
#pragma unroll
            for (int kc = 0; kc < 2; ++kc) { const bf16x8 a = *(const LAS bf16x8*)(lds + L_KT + (16 * mk + fr) * 144 + kc * 64 + fq * 16);
                c0 = MFMA16(a, Bv[kc][0], c0); c1 = MFMA16(a, Bv[kc][1], c1); }
            u32x2 w0, w1; w0.x = pk_bf16(c0[0], c0[1]); w0.y = pk_bf16(c0[2], c0[3]); w1.x = pk_bf16(c1[0], c1[1]); w1.y = pk_bf16(c1[2], c1[3]);
            *(u32x2*)(kvb + ((32 * wave + fr) * 128 + 16 * mk + 4 * fq) * 2) = w0;
            *(u32x2*)(kvb + ((32 * wave + 16 + fr) * 128 + 16 * mk + 4 * fq) * 2) = w1;
        }
        const int kd = tid >> 2, p4 = tid & 3;
        const u32x4 k0 = *(const LAS u32x4*)(lds + L_KT + kd * 144 + p4 * 32), k1 = *(const LAS u32x4*)(lds + L_KT + kd * 144 + p4 * 32 + 16);
        float ks = bf_lo(k0.x) + bf_hi(k0.x) + bf_lo(k0.y) + bf_hi(k0.y) + bf_lo(k0.z) + bf_hi(k0.z) + bf_lo(k0.w) + bf_hi(k0.w)
                 + bf_lo(k1.x) + bf_hi(k1.x) + bf_lo(k1.y) + bf_hi(k1.y) + bf_lo(k1.z) + bf_hi(k1.z) + bf_lo(k1.w) + bf_hi(k1.w);
        ks += __shfl_xor(ks, 1); ks += __shfl_xor(ks, 2);
        if (p4 == 0) ((float*)(ws + W_MLN))[(size_t)item * 128 + kd] = ks;
        if (tid == 0) { float* sc = (float*)(ws + W_MLSC) + (size_t)item * 4; sc[0] = cs; sc[1] = m_prev; sc[2] = g.b63 + g.M63; sc[3] = 0.f; }
    }
    __syncthreads();
}

__device__ __forceinline__ void ml_passB(const Params& p, int wk, int NW) {
    const int tid = opaque_tid();
    unsigned char* ws = p.ws;
    const float* sc = (const float*)(ws + W_MLSC);
    for (int task = wk * 512 + tid; task < 65536; task += NW * 512) {
        const int bh = task >> 12, e0 = (task & 4095) * 8;
        unsigned char* base = (unsigned char*)p.out + (size_t)bh * 32 * 65536 + (size_t)e0 * 2;
        float C[8];
#pragma unroll
        for (int j = 0; j < 8; ++j) C[j] = 0.f;
#pragma unroll 1
        for (int nb = 0; nb < 32; nb += 8) {
            u32x4 kv[8];
#pragma unroll
            for (int i = 0; i < 8; ++i) kv[i] = __builtin_nontemporal_load((const u32x4*)(base + (size_t)(nb + i) * 65536));
#pragma unroll
            for (int i = 0; i < 8; ++i) {
                u32x4 w; w.x = pk_bf16(C[0], C[1]); w.y = pk_bf16(C[2], C[3]); w.z = pk_bf16(C[4], C[5]); w.w = pk_bf16(C[6], C[7]);
                *(u32x4*)(base + (W_MLCS - W_MLKV) + (size_t)(nb + i) * 65536) = w;
                const float cs = sc[(size_t)(bh * 32 + nb + i) * 4];
                C[0] = cs * C[0] + bf_lo(kv[i].x); C[1] = cs * C[1] + bf_hi(kv[i].x); C[2] = cs * C[2] + bf_lo(kv[i].y); C[3] = cs * C[3] + bf_hi(kv[i].y);
                C[4] = cs * C[4] + bf_lo(kv[i].z); C[5] = cs * C[5] + bf_hi(kv[i].z); C[6] = cs * C[6] + bf_lo(kv[i].w); C[7] = cs * C[7] + bf_hi(kv[i].w);
            }
        }
        const int dv = e0 >> 7, k0 = e0 & 127;
        float* co = p.out + O_P_MLC + (size_t)bh * 32768 + (size_t)k0 * 256 + dv;
#pragma unroll
        for (int j = 0; j < 8; ++j) co[j * 256] = C[j];
    }
    for (int task = wk * 512 + tid; task < 2048; task += NW * 512) {
        const int bh = task >> 7, kd = task & 127;
        const float* mn = (const float*)(ws + W_MLN) + (size_t)bh * 32 * 128 + kd;
        float* ms = (float*)(ws + W_MLNS) + (size_t)bh * 32 * 128 + kd;
        float nn = 0.f;
#pragma unroll 1
        for (int n = 0; n < 32; ++n) { const float kn = mn[n * 128]; ms[n * 128] = nn; nn = sc[(size_t)(bh * 32 + n) * 4] * nn + kn; }
        p.out[O_P_MLN + (size_t)bh * 128 + kd] = nn;
        if (kd == 0) p.out[O_P_MLM + bh] = sc[(size_t)(bh * 32 + 31) * 4 + 2];
    }
}

__device__ __forceinline__ void ml_passC(const Params& p, LAS unsigned char* lds, int item) {
    const int tid = opaque_tid(), wave = tid >> 6, lane = tid & 63, fr = lane & 15, fq = lane >> 4;
    const int n = item & 31, bh = item >> 5, h = bh & 3, b = bh >> 2, tok0 = b * SEQL + n * 64;
    unsigned char* ws = p.ws;
    const bf16_t* proj = (const bf16_t*)(ws + W_PROJ); bf16_t* mix = (bf16_t*)(ws + W_MIX); const float* gates = (const float*)(ws + W_GATES);
    constexpr int L_QS = 0, L_KN = 17408, L_VT = 34816, L_S = 71680, L_SM = 80896, L_O = 0;
    LAS float* s_a = (LAS float*)(lds + L_SM); LAS float* s_M = s_a + 64; LAS float* s_int = s_a + 128; LAS float* s_emn = s_a + 192; LAS float* s_hd = s_a + 256;
    const float ib = p.in[14][h], fb = p.in[15][h];
    const float m_prev = ((const float*)(ws + W_MLSC))[(size_t)item * 4 + 1];
    const MlGate g = ml_gates(gates, tok0, lane, h, fb, ib, m_prev);
    if (wave == 0) { s_a[lane] = g.av; s_M[lane] = g.Mi; s_int[lane] = __expf(m_prev - g.Mi) * 0.08838834764831845f; s_emn[lane] = __expf(-(g.bc + g.Mi)); }
    const int lr = tid >> 3, lp = tid & 7;
    u32x4 zpre[4];
#pragma unroll
    for (int i = 0; i < 4; ++i) zpre[i] = *(const u32x4*)(proj + (size_t)(tok0 + (tid >> 3)) * PCOL + PC_MLO + h * 256 + (tid & 7) * 32 + 8 * i);
    {
        const bf16_t* rp = proj + (size_t)(tok0 + lr) * PCOL;
        const u32x4 pq0 = *(const u32x4*)(rp + PC_MLQ + h * 128 + lp * 16), pq1 = *(const u32x4*)(rp + PC_MLQ + h * 128 + lp * 16 + 8);
        const u32x4 pk0 = *(const u32x4*)(rp + PC_MLK + h * 128 + lp * 16), pk1 = *(const u32x4*)(rp + PC_MLK + h * 128 + lp * 16 + 8);
        u32x4 pv[4];
#pragma unroll
        for (int i = 0; i < 4; ++i) pv[i] = *(const u32x4*)(rp + PC_MLV + h * 256 + lp * 32 + i * 8);
        *(LAS u32x4*)(lds + L_QS + lr * 272 + lp * 32) = pq0; *(LAS u32x4*)(lds + L_QS + lr * 272 + lp * 32 + 16) = pq1;
        *(LAS u32x4*)(lds + L_KN + lr * 272 + lp * 32) = pk0; *(LAS u32x4*)(lds + L_KN + lr * 272 + lp * 32 + 16) = pk1;
#pragma unroll
        for (int i = 0; i < 4; ++i) { const unsigned vw[4] = {pv[i].x, pv[i].y, pv[i].z, pv[i].w};
#pragma unroll
            for (int e = 0; e < 4; ++e) {
                *(LAS bf16_t*)(lds + L_VT + (lp * 32 + i * 8 + 2 * e) * 144 + lr * 2) = (bf16_t)(vw[e] & 0xffffu);
                *(LAS bf16_t*)(lds + L_VT + (lp * 32 + i * 8 + 2 * e + 1) * 144 + lr * 2) = (bf16_t)(vw[e] >> 16);
            } }
    }
    __syncthreads();
#pragma unroll
    for (int q = 0; q < 2; ++q) {
        const int tt = wave + 8 * q, it = tt >> 2, jt = tt & 3;
        f32x4 acc = {0.f, 0.f, 0.f, 0.f};
        if (jt <= it) {
#pragma unroll
            for (int kk = 0; kk < 4; ++kk) acc = MFMA16(*(const LAS bf16x8*)(lds + L_QS + (16 * it + fr) * 272 + kk * 64 + fq * 16), *(const LAS bf16x8*)(lds + L_KN + (16 * jt + fr) * 272 + kk * 64 + fq * 16), acc);
        }
        const int j = 16 * jt + fr; const float aj = s_a[j];
#pragma unroll
        for (int e = 0; e < 4; ++e) { const int i = 16 * it + 4 * fq + e;
            const float v = (j <= i) ? acc[e] * 0.08838834764831845f * __expf(fminf(aj - s_M[i], 0.f)) : 0.f;
            *(LAS bf16_t*)(lds + L_S + i * 144 + j * 2) = f2bf(v); }
    }
    f32x4 T[4][2];
#pragma unroll
    for (int mt = 0; mt < 4; ++mt) { T[mt][0] = (f32x4){0.f, 0.f, 0.f, 0.f}; T[mt][1] = (f32x4){0.f, 0.f, 0.f, 0.f}; }
    {
        const unsigned char* cb = (const unsigned char*)p.out + 33554432 + (size_t)item * 65536;
#pragma unroll
        for (int kk = 0; kk < 4; ++kk) {
            const bf16x8 Bc0 = *(const bf16x8*)(cb + ((32 * wave + fr) * 128 + 32 * kk + 8 * fq) * 2), Bc1 = *(const bf16x8*)(cb + ((32 * wave + 16 + fr) * 128 + 32 * kk + 8 * fq) * 2);
#pragma unroll
            for (int mt = 0; mt < 4; ++mt) { const bf16x8 a = *(const LAS bf16x8*)(lds + L_QS + (16 * mt + fr) * 272 + kk * 64 + fq * 16);
                T[mt][0] = MFMA16(a, Bc0, T[mt][0]); T[mt][1] = MFMA16(a, Bc1, T[mt][1]); }
        }
#pragma unroll
        for (int mt = 0; mt < 4; ++mt)
#pragma unroll
            for (int e = 0; e < 4; ++e) { const float sc = s_int[16 * mt + 4 * fq + e]; T[mt][0][e] *= sc; T[mt][1][e] *= sc; }
    }
    __syncthreads();
    {
        const int r = tid >> 3, part = tid & 7;
        float qn = 0.f;
        { const u32x4 q0 = *(const LAS u32x4*)(lds + L_QS + r * 272 + part * 32), q1 = *(const LAS u32x4*)(lds + L_QS + r * 272 + part * 32 + 16);
          const float* np = (const float*)(ws + W_MLNS) + (size_t)item * 128 + part * 16;
          const unsigned qw[8] = {q0.x, q0.y, q0.z, q0.w, q1.x, q1.y, q1.z, q1.w};
#pragma unroll
          for (int e = 0; e < 8; ++e) qn += bf_lo(qw[e]) * np[2 * e] + bf_hi(qw[e]) * np[2 * e + 1]; }
        float rs = 0.f;
        { const u32x4 s0 = *(const LAS u32x4*)(lds + L_S + r * 144 + part * 16);
          rs = bf_lo(s0.x) + bf_hi(s0.x) + bf_lo(s0.y) + bf_hi(s0.y) + bf_lo(s0.z) + bf_hi(s0.z) + bf_lo(s0.w) + bf_hi(s0.w); }
        float den = s_int[r] * qn + rs;
        den += __shfl_xor(den, 1); den += __shfl_xor(den, 2); den += __shfl_xor(den, 4);
        if (part == 0) s_hd[r] = __builtin_amdgcn_rcpf(fmaxf(fabsf(den), s_emn[r]));
    }
    {
        bf16x8 Bv[2][2];
#pragma unroll
        for (int kc = 0; kc < 2; ++kc)
#pragma unroll
            for (int nt = 0; nt < 2; ++nt) Bv[kc][nt] = *(const LAS bf16x8*)(lds + L_VT + (32 * wave + 16 * nt + fr) * 144 + kc * 64 + fq * 16);
#pragma unroll
        for (int mt = 0; mt < 4; ++mt)
#pragma unroll
            for (int kc = 0; kc < 2; ++kc) { const bf16x8 a = *(const LAS bf16x8*)(lds + L_S + (16 * mt + fr) * 144 + kc * 64 + fq * 16);
                T[mt][0] = MFMA16(a, Bv[kc][0], T[mt][0]); T[mt][1] = MFMA16(a, Bv[kc][1], T[mt][1]); }
    }
    __syncthreads();
#pragma unroll
    for (int mt = 0; mt < 4; ++mt)
#pragma unroll
        for (int e = 0; e < 4; ++e) { const int i = 16 * mt + 4 * fq + e; const float hd = s_hd[i];
            ((LAS float*)(lds + L_O))[i * 260 + 32 * wave + fr] = T[mt][0][e] * hd; ((LAS float*)(lds + L_O))[i * 260 + 32 * wave + 16 + fr] = T[mt][1][e] * hd; }
    __syncthreads();
    {
        const int c = tid >> 3, part = tid & 7, row = tok0 + c;
        const LAS float* op = (const LAS float*)(lds + L_O) + c * 260 + part * 32;
        f32x4 v[8]; float ss = 0.f;
#pragma unroll
        for (int i = 0; i < 8; ++i) { v[i] = *(const LAS f32x4*)(op + 4 * i); ss += v[i][0] * v[i][0] + v[i][1] * v[i][1] + v[i][2] * v[i][2] + v[i][3] * v[i][3]; }
        ss += __shfl_xor(ss, 1); ss += __shfl_xor(ss, 2); ss += __shfl_xor(ss, 4);
        const float rn = rsqrtf(ss * (1.f / 256.f) + EPS);
        const bf16_t* zp = proj + (size_t)row * PCOL + PC_MLO + h * 256 + part * 32;
        const float* gp = p.in[16] + h * 256 + part * 32;
        bf16_t* mp = mix + (size_t)row * DM + 1024 + h * 256 + part * 32;
#pragma unroll
        for (int i = 0; i < 4; ++i) {
            const u32x4 z = zpre[i];
            const float zz[8] = {bf_lo(z.x), bf_hi(z.x), bf_lo(z.y), bf_hi(z.y), bf_lo(z.z), bf_hi(z.z), bf_lo(z.w), bf_hi(z.w)};
            float o[8];
#pragma unroll
            for (int e = 0; e < 8; ++e) o[e] = v[2 * i + (e >> 2)][e & 3] * rn * gp[8 * i + e] * sigm(zz[e]);
            u32x4 w; w.x = pk_bf16(o[0], o[1]); w.y = pk_bf16(o[2], o[3]); w.z = pk_bf16(o[4], o[5]); w.w = pk_bf16(o[6], o[7]);
            *(u32x4*)(mp + 8 * i) = w;
        }
    }
    __syncthreads();
}

__device__ __forceinline__ void sample_dn(const Params& p, LAS unsigned char* lds, int iter) {
    const int tid = opaque_tid(), sub = tid >> 7, j = tid & 127, wv = (tid >> 6) & 1, lane = tid & 63;
    const int item = iter * 4 + sub, s = item >> 3, h = item & 7;
    unsigned char* ws = p.ws;
    const bf16_t* proj = (const bf16_t*)(ws + W_PROJ); bf16_t* mix = (bf16_t*)(ws + W_MIX); const float* gates = (const float*)(ws + W_GATES);
    LAS float* sq = (LAS float*)(lds + sub * 24576); LAS float* sk = sq + 1024; LAS float* sv = sq + 2048; LAS float* so = sq + 3072; LAS float* sz = sq + 4096;
    LAS float* red = sq + 5120;   LAS float* sg = sq + 5152;
    const int row0 = NPT + 8 * s;
#pragma unroll
    for (int t = 0; t < 8; ++t) sz[t * 128 + j] = bf2f(proj[(size_t)(row0 + t) * PCOL + PC_DNZ + h * 128 + j]);
    float qv[8], kv[8];
#pragma unroll
    for (int sec = 0; sec < 3; ++sec) {
        const int c = sec * 1024 + h * 128 + j;
        float xp[11];
#pragma unroll
        for (int i = 0; i < 3; ++i) xp[i] = p.in[2][(size_t)(s * 3 + i) * 3072 + c];
#pragma unroll
        for (int t = 0; t < 8; ++t) xp[3 + t] = bf2f(proj[(size_t)(row0 + t) * PCOL + c]);
        const float w0 = p.in[10][c], w1 = p.in[10][3072 + c], w2 = p.in[10][6144 + c], w3 = p.in[10][9216 + c];
#pragma unroll
        for (int t = 0; t < 8; ++t) { const float v = siluf(w0 * xp[t] + w1 * xp[t + 1] + w2 * xp[t + 2] + w3 * xp[t + 3]);
            if (sec == 0) qv[t] = v; else if (sec == 1) kv[t] = v; else sv[t * 128 + j] = v; }
    }
    {
        float ra[8], rb[8];
#pragma unroll
        for (int t = 0; t < 8; ++t) { ra[t] = qv[t] * qv[t]; rb[t] = kv[t] * kv[t]; }
#pragma unroll
        for (int d = 32; d >= 1; d >>= 1) {
#pragma unroll
            for (int t = 0; t < 8; ++t) { ra[t] += __shfl_xor(ra[t], d); rb[t] += __shfl_xor(rb[t], d); }
        }
        if (lane == 0) {
#pragma unroll
            for (int t = 0; t < 8; ++t) { red[wv * 16 + t] = ra[t]; red[wv * 16 + 8 + t] = rb[t]; }
        }
    }
    if (j < 8) { const int row = row0 + j;
        sg[2 * j] = __expf(-__expf(p.in[11][h]) * softplusf(gates[(size_t)row * 32 + 8 + h] + p.in[12][h]));
        sg[2 * j + 1] = sigm(gates[(size_t)row * 32 + h]); }
    __syncthreads();
#pragma unroll
    for (int t = 0; t < 8; ++t) {
        sq[t * 128 + j] = qv[t] * rsqrtf(red[t] + red[16 + t] + EPS) * 0.08838834764831845f;
        sk[t * 128 + j] = kv[t] * rsqrtf(red[8 + t] + red[24 + t] + EPS);
    }
    float S[128];
    const float* sp = p.in[3] + ((size_t)(s * 8 + h) * 128) * 128 + j;
#pragma unroll
    for (int k = 0; k < 128; ++k) S[k] = __builtin_nontemporal_load(sp + (size_t)k * 128);
    __syncthreads();
#pragma unroll 1
    for (int t = 0; t < 8; ++t) {
        const float a = sg[2 * t], be = sg[2 * t + 1], vt = sv[t * 128 + j];
        float kvs = 0.f;
#pragma unroll
        for (int k4 = 0; k4 < 32; ++k4) { const f32x4 kk = *(const LAS f32x4*)(sk + t * 128 + 4 * k4);
            kvs += S[4 * k4] * kk[0] + S[4 * k4 + 1] * kk[1] + S[4 * k4 + 2] * kk[2] + S[4 * k4 + 3] * kk[3];
            if ((k4 & 7) == 7) __builtin_amdgcn_sched_barrier(0); }
        const float delta = be * (vt - a * kvs);
        float o = 0.f;
#pragma unroll
        for (int k4 = 0; k4 < 32; ++k4) { const f32x4 kk = *(const LAS f32x4*)(sk + t * 128 + 4 * k4), qq = *(const LAS f32x4*)(sq + t * 128 + 4 * k4);
#pragma unroll
            for (int e = 0; e < 4; ++e) { S[4 * k4 + e] = a * S[4 * k4 + e] + kk[e] * delta; o += S[4 * k4 + e] * qq[e]; }
            if ((k4 & 3) == 3) __builtin_amdgcn_sched_barrier(0); }
        so[t * 128 + j] = o;
    }
    float* dp = p.out + O_S_DNS + ((size_t)(s * 8 + h) * 128) * 128 + j;
#pragma unroll
    for (int k = 0; k < 128; ++k) __builtin_nontemporal_store(S[k], dp + (size_t)k * 128);
    float ov[8];
    {
        float ra[8];
#pragma unroll
        for (int t = 0; t < 8; ++t) { ov[t] = so[t * 128 + j]; ra[t] = ov[t] * ov[t]; }
#pragma unroll
        for (int d = 32; d >= 1; d >>= 1) {
#pragma unroll
            for (int t = 0; t < 8; ++t) ra[t] += __shfl_xor(ra[t], d);
        }
        if (lane == 0) {
#pragma unroll
            for (int t = 0; t < 8; ++t) red[wv * 16 + t] = ra[t];
        }
    }
    __syncthreads();
    const float gn = p.in[13][j];
#pragma unroll
    for (int t = 0; t < 8; ++t) {
        const float rn = rsqrtf((red[t] + red[16 + t]) * (1.f / 128.f) + EPS);
        mix[(size_t)(row0 + t) * DM + h * 128 + j] = f2bf(ov[t] * rn * gn * siluf(sz[t * 128 + j]));
    }
    __syncthreads();
}

__device__ __forceinline__ void sample_ml(const Params& p, LAS unsigned char* lds, int iter) {
    const int tid = opaque_tid(), sub = tid >> 8, j = tid & 255, wv = (tid >> 6) & 3, lane = tid & 63;
    const int item = iter * 2 + sub, s = item >> 2, h = item & 3;
    unsigned char* ws = p.ws;
    const bf16_t* proj = (const bf16_t*)(ws + W_PROJ); bf16_t* mix = (bf16_t*)(ws + W_MIX); const float* gates = (const float*)(ws + W_GATES);
    LAS float* sq = (LAS float*)(lds + sub * 40960); LAS float* sk = sq + 1024; LAS float* sv = sq + 2048;   LAS float* sh = sq + 4096;
    LAS float* sz = sq + 6144;   LAS float* red = sq + 8192;   LAS float* sgt = sq + 8224;   LAS float* sgr = sq + 8256;
    const int row0 = NPT + 8 * s;
#pragma unroll
    for (int t = 0; t < 8; ++t) sz[t * 256 + j] = bf2f(proj[(size_t)(row0 + t) * PCOL + PC_MLO + h * 256 + j]);
    if (j < 8) { sgr[2 * j] = logsigm(gates[(size_t)(row0 + j) * 32 + 20 + h] + p.in[15][h]); sgr[2 * j + 1] = gates[(size_t)(row0 + j) * 32 + 16 + h] + p.in[14][h]; }
    if (j < 128) {
#pragma unroll
        for (int t = 0; t < 8; ++t) {
            sq[t * 128 + j] = bf2f(proj[(size_t)(row0 + t) * PCOL + PC_MLQ + h * 128 + j]) * 0.08838834764831845f;
            sk[t * 128 + j] = bf2f(proj[(size_t)(row0 + t) * PCOL + PC_MLK + h * 128 + j]);
        }
    }
#pragma unroll
    for (int t = 0; t < 8; ++t) sv[t * 256 + j] = bf2f(proj[(size_t)(row0 + t) * PCOL + PC_MLV + h * 256 + j]);
    float Cc[128];
    const float* cp = p.in[4] + ((size_t)(s * 4 + h) * 128) * 256 + j;
#pragma unroll
    for (int k = 0; k < 128; ++k) Cc[k] = __builtin_nontemporal_load(cp + (size_t)k * 256);
    float nj = 0.f;
    if (j < 128) nj = p.in[5][(size_t)(s * 4 + h) * 128 + j];
    const float m0 = p.in[6][s * 4 + h];
    __syncthreads();
    {
        float pd[8]; float m = m0;
#pragma unroll
        for (int t = 0; t < 8; ++t) {
            const float f = sgr[2 * t], ig = sgr[2 * t + 1];
            const float mn = fmaxf(f + m, ig), fp = __expf(f + m - mn), ip = __expf(ig - mn);
            if (j == 0) { sgt[4 * t] = fp; sgt[4 * t + 1] = ip; sgt[4 * t + 2] = __expf(-mn); sgt[4 * t + 3] = mn; }
            m = mn;
            pd[t] = 0.f;
            if (j < 128) { nj = fp * nj + ip * sk[t * 128 + j]; pd[t] = nj * sq[t * 128 + j]; }
        }
#pragma unroll
        for (int d = 32; d >= 1; d >>= 1) {
#pragma unroll
            for (int t = 0; t < 8; ++t) pd[t] += __shfl_xor(pd[t], d);
        }
        if (lane == 0) {
#pragma unroll
            for (int t = 0; t < 8; ++t) red[wv * 8 + t] = pd[t];
        }
    }
    __syncthreads();
#pragma unroll 1
    for (int t = 0; t < 8; ++t) {
        const float f = sgt[4 * t], iv = sgt[4 * t + 1] * sv[t * 256 + j];
        float num = 0.f;
#pragma unroll
        for (int k4 = 0; k4 < 32; ++k4) { const f32x4 kk = *(const LAS f32x4*)(sk + t * 128 + 4 * k4), qq = *(const LAS f32x4*)(sq + t * 128 + 4 * k4);
#pragma unroll
            for (int e = 0; e < 4; ++e) { Cc[4 * k4 + e] = f * Cc[4 * k4 + e] + kk[e] * iv; num += Cc[4 * k4 + e] * qq[e]; }
            if ((k4 & 3) == 3) __builtin_amdgcn_sched_barrier(0); }
        const float den = red[t] + red[8 + t] + red[16 + t] + red[24 + t];
        sh[t * 256 + j] = num * __builtin_amdgcn_rcpf(fmaxf(fabsf(den), sgt[4 * t + 2]));
    }
    float* dp = p.out + O_S_MLC + ((size_t)(s * 4 + h) * 128) * 256 + j;
#pragma unroll
    for (int k = 0; k < 128; ++k) __builtin_nontemporal_store(Cc[k], dp + (size_t)k * 256);
    if (j < 128) p.out[O_S_MLN + (size_t)(s * 4 + h) * 128 + j] = nj;
    if (j == 0) p.out[O_S_MLM + s * 4 + h] = sgt[31];
    __syncthreads();
    float hv[8];
    {
        float ra[8];
#pragma unroll
        for (int t = 0; t < 8; ++t) { hv[t] = sh[t * 256 + j]; ra[t] = hv[t] * hv[t]; }
#pragma unroll
        for (int d = 32; d >= 1; d >>= 1) {
#pragma unroll
            for (int t = 0; t < 8; ++t) ra[t] += __shfl_xor(ra[t], d);
        }
        if (lane == 0) {
#pragma unroll
            for (int t = 0; t < 8; ++t) red[wv * 8 + t] = ra[t];
        }
    }
    __syncthreads();
    const float gn = p.in[16][h * 256 + j];
#pragma unroll
    for (int t = 0; t < 8; ++t) {
        const float rn = rsqrtf((red[t] + red[8 + t] + red[16 + t] + red[24 + t]) * (1.f / 256.f) + EPS);
        mix[(size_t)(row0 + t) * DM + 1024 + h * 256 + j] = f2bf(hv[t] * rn * gn * sigm(sz[t * 256 + j]));
    }
    __syncthreads();
}

__device__ __forceinline__ void phase6(const Params& p) {
    const int tid = opaque_tid();
    unsigned char* ws = p.ws;
    const bf16_t* u = (const bf16_t*)(ws + W_PROJ); bf16_t* act = (bf16_t*)(ws + W_WIN);
    const float* cw = p.in[20]; const float* cb = p.in[21]; const float* st = p.in[7];
    const int gt = blockIdx.x * 512 + tid, GT = gridDim.x * 512;
    for (int task = gt; task < 144 * 704; task += GT) {
        const int cgp = task % 704, chunk = task / 704, R0 = chunk * 64, c0 = cgp * 8;
        const bool smp = R0 >= NPT;
        f32x4 wg[3][2], wu[3][2], bgv[2], buv[2];
#pragma unroll
        for (int jj = 0; jj < 3; ++jj) { wg[jj][0] = *(const f32x4*)(cw + (size_t)jj * FF2 + c0); wg[jj][1] = *(const f32x4*)(cw + (size_t)jj * FF2 + c0 + 4);
            wu[jj][0] = *(const f32x4*)(cw + (size_t)jj * FF2 + FF + c0); wu[jj][1] = *(const f32x4*)(cw + (size_t)jj * FF2 + FF + c0 + 4); }
        bgv[0] = *(const f32x4*)(cb + c0); bgv[1] = *(const f32x4*)(cb + c0 + 4); buv[0] = *(const f32x4*)(cb + FF + c0); buv[1] = *(const f32x4*)(cb + FF + c0 + 4);
        u32x4 xg[10], xu[10];
        if (!smp && (R0 % SEQL) != 0) {
#pragma unroll
            for (int i = 0; i < 2; ++i) { const bf16_t* rp = u + (size_t)(R0 - 2 + i) * FF2 + c0; xg[i] = *(const u32x4*)rp; xu[i] = *(const u32x4*)(rp + FF); }
        } else {
#pragma unroll
            for (int i = 0; i < 2; ++i) { xg[i] = (u32x4){0u, 0u, 0u, 0u}; xu[i] = (u32x4){0u, 0u, 0u, 0u}; }
        }
#pragma unroll 1
        for (int run = 0; run < 8; ++run) {
            const int row0 = R0 + 8 * run;
#pragma unroll
            for (int i = 2; i < 10; ++i) { const bf16_t* rp = u + (size_t)(row0 - 2 + i) * FF2 + c0; xg[i] = *(const u32x4*)rp; xu[i] = *(const u32x4*)(rp + FF); }
            if (smp) {
#pragma unroll
                for (int i = 0; i < 2; ++i) {
                    const float* sp = st + ((size_t)((row0 - NPT) >> 3) * 2 + i) * FF2 + c0;
                    xg[i] = pack8(*(const f32x4*)sp, *(const f32x4*)(sp + 4)); xu[i] = pack8(*(const f32x4*)(sp + FF), *(const f32x4*)(sp + FF + 4));
                }
            }
#define CVL(v) ((f32x4){bf_lo((v).x), bf_hi((v).x), bf_lo((v).y), bf_hi((v).y)})
#define CVH(v) ((f32x4){bf_lo((v).z), bf_hi((v).z), bf_lo((v).w), bf_hi((v).w)})
            {
                f32x4 ga0 = CVL(xg[0]), ga1 = CVH(xg[0]), gb0 = CVL(xg[1]), gb1 = CVH(xg[1]);
                f32x4 ua0 = CVL(xu[0]), ua1 = CVH(xu[0]), ub0 = CVL(xu[1]), ub1 = CVH(xu[1]);
#pragma unroll
                for (int r = 0; r < 8; ++r) {
                    const f32x4 gc0 = CVL(xg[r + 2]), gc1 = CVH(xg[r + 2]), uc0 = CVL(xu[r + 2]), uc1 = CVH(xu[r + 2]);
                    const f32x4 g0 = bgv[0] + wg[0][0] * ga0 + wg[1][0] * gb0 + wg[2][0] * gc0;
                    const f32x4 g1 = bgv[1] + wg[0][1] * ga1 + wg[1][1] * gb1 + wg[2][1] * gc1;
                    const f32x4 u0 = buv[0] + wu[0][0] * ua0 + wu[1][0] * ub0 + wu[2][0] * uc0;
                    const f32x4 u1 = buv[1] + wu[0][1] * ua1 + wu[1][1] * ub1 + wu[2][1] * uc1;
                    u32x4 w; w.x = pk_bf16(siluf(g0[0]) * u0[0], siluf(g0[1]) * u0[1]); w.y = pk_bf16(siluf(g0[2]) * u0[2], siluf(g0[3]) * u0[3]);
                    w.z = pk_bf16(siluf(g1[0]) * u1[0], siluf(g1[1]) * u1[1]); w.w = pk_bf16(siluf(g1[2]) * u1[2], siluf(g1[3]) * u1[3]);
                    *(u32x4*)(act + (size_t)(row0 + r) * FF + c0) = w;
                    ga0 = gb0; ga1 = gb1; gb0 = gc0; gb1 = gc1; ua0 = ub0; ua1 = ub1; ub0 = uc0; ub1 = uc1;
                }
            }
#undef CVL
#undef CVH
            xg[0] = xg[8]; xg[1] = xg[9]; xu[0] = xu[8]; xu[1] = xu[9];
        }
    }
    float* out = p.out;
    for (int i = gt; i < 128 * 2 * FF2; i += GT) { const int c = i % FF2, j = (i / FF2) & 1, s = i / (2 * FF2);
        out[O_S_FFN + i] = bf2f(u[(size_t)(NPT + 8 * s + 6 + j) * FF2 + c]); }
    for (int i = gt; i < 4 * 2 * FF2; i += GT) { const int c = i % FF2, j = (i / FF2) & 1, b = i / (2 * FF2);
        out[O_P_FFN + i] = bf2f(u[(size_t)(b * SEQL + 2046 + j) * FF2 + c]); }
}

__device__ __forceinline__ void phase8(const Params& p) {
    const int tid = opaque_tid(), wave = tid >> 6, lane = tid & 63;
    const float* p1 = (const float*)(p.ws + W_PROJ); const float* g = p.in[23];
    float* y = p.out + O_Y;
    for (int row = blockIdx.x * 8 + wave; row < NTOK; row += gridDim.x * 8) {
        float* yr = y + (size_t)row * DM; const float* pr = p1 + (size_t)row * DM;
        f32x4 v[8]; float ss = 0.f;
#pragma unroll
        for (int i = 0; i < 8; ++i) { const int c = i * 256 + lane * 4; v[i] = *(const f32x4*)(yr + c) + *(const f32x4*)(pr + c);
            ss += v[i][0] * v[i][0] + v[i][1] * v[i][1] + v[i][2] * v[i][2] + v[i][3] * v[i][3]; }
        ss = wave_sum(ss);
        const float rn = rsqrtf(ss * (1.f / 2048.f) + EPS);
#pragma unroll
        for (int i = 0; i < 8; ++i) { const int c = i * 256 + lane * 4; const f32x4 gg = *(const f32x4*)(g + c);
            __builtin_nontemporal_store((f32x4){v[i][0] * rn * gg[0], v[i][1] * rn * gg[1], v[i][2] * rn * gg[2], v[i][3] * rn * gg[3]}, (f32x4*)(yr + c)); }
    }
}

#define XB_TMO      128
#define XB_XCNT(j)  (256  + 64 * (j))
#define XB_XSUB(j)  (1280 + 64 * (j))
#define XB_XGEN(j)  (2304 + 64 * (j))
#define XB_TOP      3328
#define XB_TOPGEN   3392
#define XCD_BAR_WORDS 3456
#define XB_SPIN_CAP (1u << 18)

__device__ __forceinline__ unsigned xb_ld(unsigned* p)              { return __hip_atomic_load(p, __ATOMIC_RELAXED, __HIP_MEMORY_SCOPE_AGENT); }
__device__ __forceinline__ unsigned xb_add(unsigned* p, unsigned v) { return __hip_atomic_fetch_add(p, v, __ATOMIC_RELAXED, __HIP_MEMORY_SCOPE_AGENT); }
__device__ __forceinline__ unsigned xb_xcc_id() { return (unsigned)__builtin_amdgcn_s_getreg((3 << 11) | 20) & 0xFu; }
#define XB_SPIN(cond, bar) do { unsigned _sp = 0; while (cond) { __builtin_amdgcn_s_sleep(1); \
    if ((++_sp & 255u) == 0u) { if (xb_ld(&(bar)[XB_TMO])) break; if (_sp > XB_SPIN_CAP) { atomicAdd(&(bar)[XB_TMO], 1u); break; } } } } while (0)

struct XcdBarrier {
    unsigned* bar; unsigned x;
    volatile LAS unsigned* st;
};

__device__ __forceinline__ XcdBarrier xcd_barrier_post(unsigned* bar, volatile LAS unsigned* st) {
    XcdBarrier b; b.bar = bar; b.x = xb_xcc_id(); b.st = st;
    if (threadIdx.x == 0) (void)xb_add(&bar[XB_XCNT(b.x)], 1u);
    return b;
}
__device__ __forceinline__ void xcd_barrier_complete(unsigned* bar, unsigned x, unsigned& nloc, unsigned& nx) {
    const unsigned G = gridDim.x * gridDim.y * gridDim.z;
    unsigned sum, cnt, mine, sp = 0u;
    for (;;) {
        sum = 0u; cnt = 0u; mine = 0u;
#pragma unroll
        for (unsigned j = 0; j < 16; ++j) { const unsigned c = xb_ld(&bar[XB_XCNT(j)]); sum += c; cnt += (c > 0u) ? 1u : 0u; mine = (j == x) ? c : mine; }
        if (sum == G) break;
        __builtin_amdgcn_s_sleep(1);
        if ((++sp & 255u) == 0u) { if (xb_ld(&bar[XB_TMO])) break; if (sp > XB_SPIN_CAP) { atomicAdd(&bar[XB_TMO], 1u); break; } }
    }
    nloc = mine > 0u ? mine : 1u; nx = cnt > 0u ? cnt : 1u;
}

__device__ __forceinline__ void xcd_barrier(const XcdBarrier& b) {
    asm volatile("s_waitcnt vmcnt(0)" ::: "memory");
    __syncthreads();
    if (threadIdx.x == 0) {
        unsigned* bar = b.bar;
        __builtin_amdgcn_s_waitcnt(0);
        unsigned nloc = b.st[0], nx = b.st[1];
        if (nloc == 0u) { xcd_barrier_complete(bar, b.x, nloc, nx); b.st[0] = nloc; b.st[1] = nx; }
        const unsigned old = xb_add(&bar[XB_XSUB(b.x)], 1u);
        const unsigned gen = old / nloc;
        if (old + 1u == (gen + 1u) * nloc) {
            __builtin_amdgcn_fence(__ATOMIC_RELEASE, "agent");
            asm volatile("s_waitcnt vmcnt(0)" ::: "memory");
            const unsigned og = xb_add(&bar[XB_TOP], 1u);
            const unsigned tg = og / nx;
            if (og + 1u == (tg + 1u) * nx) xb_add(&bar[XB_TOPGEN], 1u);
            else XB_SPIN(xb_ld(&bar[XB_TOPGEN]) == tg, bar);
            __builtin_amdgcn_fence(__ATOMIC_ACQUIRE, "agent");
            xb_add(&bar[XB_XGEN(b.x)], 1u);
            asm volatile("s_waitcnt vmcnt(0)" ::: "memory");
        } else {
            XB_SPIN(xb_ld(&bar[XB_XGEN(b.x)]) == gen, bar);
            __builtin_amdgcn_fence(__ATOMIC_ACQUIRE, "agent");
            asm volatile("s_waitcnt vmcnt(0)" ::: "memory");
        }
    }
    __syncthreads();
}


#define GSYNC() do { asm volatile("s_waitcnt vmcnt(0)" ::: "memory"); grid.sync(); } while (0)
extern __shared__ __attribute__((aligned(16))) unsigned char smem_raw[];

__global__ void __launch_bounds__(512) hymba_fwd(Params p) {
    cg::grid_group grid = cg::this_grid();
    LAS unsigned char* lds = (LAS unsigned char*)smem_raw;
    unsigned char* ws = p.ws;
    pg8::StaticOrder so;
    unsigned* xbar = (unsigned*)(ws + W_BAR);
    volatile LAS unsigned* xst = (volatile LAS unsigned*)(lds + LDS_BYTES - 16);
    if (blockIdx.x == 0) for (int i = threadIdx.x; i < XCD_BAR_WORDS; i += 512) xbar[i] = 0u;
    if (threadIdx.x == 0) { xst[0] = 0u; xst[1] = 0u; }
    __syncthreads();
    GSYNC();
    const XcdBarrier xb = xcd_barrier_post(xbar, xst);
#define XSYNC() xcd_barrier(xb)
    phase0(p, lds);
    XSYNC();
    for (int rep = 0; rep <= DUP_P1; ++rep) {
        so.init(NTOK, PCOL, gridDim.x, blockIdx.x);
        pg8::Gemm g{(const bf16_t*)(ws + W_XB), (const bf16_t*)(ws + W_WIN), NTOK, PCOL, DM, DM, 1};
        EpiScaleBf16<false> e{(bf16_t*)(ws + W_PROJ), PCOL, (const float*)(ws + W_RSTD1)};
        pg8::gemm_phase(lds, g, so, e);
    XSYNC();
    }
    for (int rep = 0; rep <= DUP_P2; ++rep) {
    phase2(p, lds);
    for (int item = blockIdx.x; item < 512; item += gridDim.x) ml_passA(p, lds, item);
    XSYNC();
    }
    {
        const int blk = blockIdx.x;
        unsigned* cdone = (unsigned*)(ws + W_CTR);
        if (blk < 32) scan_dn(p, lds, blk);
        else {
            const int wk = blk - 32, NW = gridDim.x - 32;
            const bool wide = NW >= 224;
            const int pb0 = wide ? 64 : 0, npb = wide ? 128 : (NW < 128 ? NW : 128), g0 = wide ? 192 : 64;
            if (wk >= pb0 && wk < pb0 + npb) { ml_passB(p, wk - pb0, npb); signal_done(cdone + 32); }
            for (int it = wk; it < 512; it += NW) { if (it < 256) sample_dn(p, lds, it); else sample_ml(p, lds, it - 256); }
            signal_done(cdone + 48);
            wait_count(cdone + 32, (unsigned)npb);
            for (int item = wk; item < 512; item += NW) ml_passC(p, lds, item);
            if (wk >= g0 && wk < g0 + 32) {
                wait_count(cdone + 48, (unsigned)NW);
                pg8::OneUnit ou{32 + ((wk - g0) >> 3), (wk - g0) & 7};
                pg8::Gemm g{(const bf16_t*)(ws + W_MIX), (const bf16_t*)(ws + W_WOUT), NTOK, DM, DM, DM, 1};
                EpiResid e{p.in[0], p.in[1], p.out + O_Y, (bf16_t*)(ws + W_XB), (float*)(ws + W_SSP2), nullptr};
                pg8::gemm_phase(lds, g, ou, e);
            }
        }
        convert_late(p);
    }
    XSYNC();
    {
        so.init(NPT, DM, gridDim.x, blockIdx.x);
        pg8::Gemm g{(const bf16_t*)(ws + W_MIX), (const bf16_t*)(ws + W_WOUT), NPT, DM, DM, DM, 1};
        EpiResid e{p.in[0], p.in[1], p.out + O_Y, (bf16_t*)(ws + W_XB), (float*)(ws + W_SSP2), nullptr};
        pg8::gemm_phase(lds, g, so, e);
    }
    XSYNC();
    for (int rep = 0; rep <= DUP_P5; ++rep) {
        so.init(NTOK, FF2, gridDim.x, blockIdx.x);
        pg8::Gemm g{(const bf16_t*)(ws + W_XB), (const bf16_t*)(ws + W_WUP), NTOK, FF2, DM, DM, 1};
        EpiScaleBf16<true> e{(bf16_t*)(ws + W_PROJ), FF2, (const float*)(ws + W_SSP2)};
        pg8::gemm_phase(lds, g, so, e);
    XSYNC();
    }
    for (int rep = 0; rep <= DUP_P6; ++rep) {
    phase6(p);
    XSYNC();
    }
    {
        so.init(NTOK, 2 * DM, gridDim.x, blockIdx.x);
        pg8::Gemm g{(const bf16_t*)(ws + W_WIN), (const bf16_t*)(ws + W_WDOWN), NTOK, DM, FF / 2, FF, 2};
        EpiResid e{p.out + O_Y, p.out + O_Y + (size_t)NPT * DM, p.out + O_Y, nullptr, nullptr, (float*)(ws + W_PROJ)};
        pg8::gemm_phase(lds, g, so, e);
    }
    XSYNC();
    phase8(p);
}

extern "C" void kernel_launch(void* const* d_in, const int* in_sizes, int n_in, void* d_out, int out_size, void* d_ws, size_t ws_size, hipStream_t stream) {
    static int grid_blocks = 0;
    if (grid_blocks == 0) {
        if (n_in != 24 || (size_t)out_size != O_TOTAL || ws_size < W_END2) { fprintf(stderr, "kernel_launch: unexpected shapes (n_in %d out %d ws %zu need %zu)\n", n_in, out_size, ws_size, (size_t)W_END2); grid_blocks = -1; return; }
        int dev = 0, cus = 0, per_cu = 0;
        hipGetDevice(&dev);
        hipDeviceGetAttribute(&cus, hipDeviceAttributeMultiprocessorCount, dev);
        if (hipFuncSetAttribute((const void*)hymba_fwd, hipFuncAttributeMaxDynamicSharedMemorySize, LDS_BYTES) != hipSuccess) { fprintf(stderr, "hipFuncSetAttribute failed\n"); grid_blocks = -1; return; }
        if (hipOccupancyMaxActiveBlocksPerMultiprocessor(&per_cu, (const void*)hymba_fwd, 512, LDS_BYTES) != hipSuccess || per_cu < 1) { fprintf(stderr, "occupancy query failed\n"); grid_blocks = -1; return; }
        grid_blocks = cus * (per_cu > 1 ? 1 : per_cu);
    }
    if (grid_blocks < 0) return;
    Params p{};
    for (int i = 0; i < 24; ++i) p.in[i] = (const float*)d_in[i];
    p.out = (float*)d_out; p.ws = (unsigned char*)d_ws;
    void* args[] = {&p};
    hipError_t e = hipLaunchCooperativeKernel((const void*)hymba_fwd, dim3(grid_blocks), dim3(512), args, LDS_BYTES, stream);
    if (e != hipSuccess) fprintf(stderr, "cooperative launch failed: %s (grid %d)\n", hipGetErrorString(e), grid_blocks);
}
```
